# Optimizing an MI355X kernel written in HIP

```python
import math
import jax, jax.numpy as jnp
from jax import lax
import numpy as np

D_MODEL = 1024
BATCH = 16
SEQ = 256
DEPTH = 1
DEC_BATCH = 2
DEC_SEQ = 4096
PAST_LEN = 512

GRID_W = 64
POS_BASE = 10000.0
D_SSD = 1024
SSD_HEAD_DIM = 64
SSD_HEADS = D_SSD // SSD_HEAD_DIM
SSD_GROUPS = 2
SSD_HPG = SSD_HEADS // SSD_GROUPS
SSD_STATE = 128
SSD_CONV = 3
SSD_CHUNK = 128
SSD_CONV_DIM = D_SSD + 2 * SSD_GROUPS * SSD_STATE
D_SGU = 1024
SGU_GROUPS = 8
SGU_GROUP_DIM = D_SGU // SGU_GROUPS
SGU_CHUNK = 128
D_FF = 4 * D_MODEL
D_IN_PROJ = D_SSD + SSD_CONV_DIM + 2 * SSD_HEADS + 2 * D_SGU + 2 * D_MODEL
DN_ALPHA = (2.0 * DEPTH) ** 0.25
DN_BETA = (8.0 * DEPTH) ** -0.25
EPS = 1e-5

kernel_name = 'hybrid_ssd_sgu_diffusion_step'


def layer_norm(x, g, b):
    xf = x.astype(jnp.float32)
    mu = jnp.mean(xf, axis=-1, keepdims=True)
    var = jnp.mean(jnp.square(xf - mu), axis=-1, keepdims=True)
    return ((xf - mu) * lax.rsqrt(var + EPS)).astype(x.dtype) * g + b


def rms_norm(x, g):
    xf = x.astype(jnp.float32)
    ms = jnp.mean(jnp.square(xf), axis=-1, keepdims=True)
    return (xf * lax.rsqrt(ms + EPS)).astype(x.dtype) * g


def grid_pos_embed(n_tokens, dtype):
    rows = n_tokens // GRID_W
    quarter = D_MODEL // 4
    omega = 1.0 / (POS_BASE ** (jnp.arange(quarter, dtype=jnp.float32) / quarter))
    r = jnp.arange(rows, dtype=jnp.float32)[:, None] * omega
    col = jnp.arange(GRID_W, dtype=jnp.float32)[:, None] * omega
    emb_r = jnp.concatenate([jnp.sin(r), jnp.cos(r)], axis=-1)
    emb_c = jnp.concatenate([jnp.sin(col), jnp.cos(col)], axis=-1)
    emb = jnp.concatenate([
        jnp.broadcast_to(emb_r[:, None, :], (rows, GRID_W, D_MODEL // 2)),
        jnp.broadcast_to(emb_c[None, :, :], (rows, GRID_W, D_MODEL // 2))], axis=-1)
    return emb.reshape(rows * GRID_W, D_MODEL).astype(dtype)


def depthwise_conv(x, w, b):
    out = lax.conv_general_dilated(
        x, w[:, None, :], window_strides=(1,), padding='SAME',
        dimension_numbers=('NWC', 'WIO', 'NWC'), feature_group_count=x.shape[-1])
    return out + b


def ssd_chunked_scan(x, dt, a_neg, B, C, h0):
    out_dtype = x.dtype
    f32 = jnp.float32
    bsz, L = x.shape[0], x.shape[1]
    nc = L // SSD_CHUNK
    xs = x.astype(f32).reshape(bsz, nc, SSD_CHUNK, SSD_GROUPS, SSD_HPG, SSD_HEAD_DIM)
    dtc = dt.astype(f32).reshape(bsz, nc, SSD_CHUNK, SSD_GROUPS, SSD_HPG)
    a = dtc * a_neg.astype(f32).reshape(SSD_GROUPS, SSD_HPG)
    xdt = xs * dtc[..., None]
    Bc = B.astype(f32).reshape(bsz, nc, SSD_CHUNK, SSD_GROUPS, SSD_STATE)
    Cc = C.astype(f32).reshape(bsz, nc, SSD_CHUNK, SSD_GROUPS, SSD_STATE)
    acum = jnp.moveaxis(jnp.cumsum(a, axis=2), 2, -1)
    seg = acum[..., :, None] - acum[..., None, :]
    lower = jnp.tril(jnp.ones((SSD_CHUNK, SSD_CHUNK), dtype=bool))
    decay = jnp.exp(jnp.where(lower, seg, -jnp.inf))
    cb = jnp.einsum('bcign,bcjgn->bcgij', Cc, Bc)
    y_diag = jnp.einsum('bcgij,bcgrij,bcjgrp->bcigrp', cb, decay, xdt)
    a_last = acum[..., -1]
    decay_to_end = jnp.exp(a_last[..., None] - acum)
    states = jnp.einsum('bcjgn,bcgrj,bcjgrp->bcgrpn', Bc, decay_to_end, xdt)
    h_init = h0.astype(f32).reshape(bsz, SSD_GROUPS, SSD_HPG, SSD_HEAD_DIM, SSD_STATE)

    def step(h, inp):
        st, al = inp
        return jnp.exp(al)[..., None, None] * h + st, h

    h_final, h_starts = lax.scan(step, h_init,
                                 (jnp.moveaxis(states, 1, 0), jnp.moveaxis(a_last, 1, 0)))
    h_starts = jnp.moveaxis(h_starts, 0, 1)
    y_off = jnp.einsum('bcign,bcgri,bcgrpn->bcigrp', Cc, jnp.exp(acum), h_starts)
    y = (y_diag + y_off).reshape(bsz, L, SSD_HEADS, SSD_HEAD_DIM)
    return (y.astype(out_dtype),
            h_final.reshape(bsz, SSD_HEADS, SSD_HEAD_DIM, SSD_STATE).astype(out_dtype))


def ssd_bidirectional(z, xbc, dt_raw, h0_f, h0_b, conv_w, conv_b, dt_bias_f, dt_bias_b,
                      a_log_f, a_log_b, d_skip, norm_w):
    bsz, L, _ = z.shape
    gn = SSD_GROUPS * SSD_STATE
    xbc = jax.nn.silu(depthwise_conv(xbc, conv_w, conv_b))
    xh = xbc[..., :D_SSD].reshape(bsz, L, SSD_HEADS, SSD_HEAD_DIM)
    B = xbc[..., D_SSD:D_SSD + gn].reshape(bsz, L, SSD_GROUPS, SSD_STATE)
    C = xbc[..., D_SSD + gn:].reshape(bsz, L, SSD_GROUPS, SSD_STATE)
    dt_f = jax.nn.softplus(dt_raw[..., :SSD_HEADS] + dt_bias_f)
    dt_b = jax.nn.softplus(dt_raw[..., SSD_HEADS:] + dt_bias_b)
    y_f, h_f = ssd_chunked_scan(xh, dt_f, -jnp.exp(a_log_f), B, C, h0_f)
    flip = lambda t: jnp.flip(t, axis=1)
    y_b, h_b = ssd_chunked_scan(flip(xh), flip(dt_b), -jnp.exp(a_log_b), flip(B), flip(C), h0_b)
    y = y_f + flip(y_b) + d_skip[:, None] * xh
    y = y.reshape(bsz, L, D_SSD)
    y = rms_norm(y * jax.nn.silu(z), norm_w)
    return y, h_f, h_b


def chunk_sgu(uv, ln_g, ln_b, w_spatial, b_spatial):
    uv = jax.nn.gelu(uv, approximate=False)
    u, v = uv[..., :D_SGU], uv[..., D_SGU:]
    v = layer_norm(v, ln_g, ln_b)
    bsz, L, _ = v.shape
    nc = L // SGU_CHUNK
    vg = v.reshape(bsz, nc, SGU_CHUNK, SGU_GROUPS, SGU_GROUP_DIM)
    s = jnp.einsum('gij,bcjgd->bcigd', w_spatial, vg) + jnp.swapaxes(b_spatial, 0, 1)[None, None, :, :, None]
    return u * s.reshape(bsz, L, D_SGU)


def trunk_layer(x, mod, h0_f, h0_b, w_in, conv_w, conv_b, dt_bias_f, dt_bias_b, a_log_f, a_log_b,
                d_skip, ssd_norm_w, sgu_ln_g, sgu_ln_b, w_spatial, b_spatial, w_proj_a, w_proj_b,
                w_out, ln1_g, ln1_b, w_ff1, w_ff2, ln2_g, ln2_b):
    shift1, scale1, gate1, shift2, scale2, gate2 = jnp.split(mod, 6, axis=-1)
    h = x * (1.0 + scale1) + shift1
    proj = h @ w_in
    o1 = D_SSD
    o2 = o1 + SSD_CONV_DIM
    o3 = o2 + 2 * SSD_HEADS
    o4 = o3 + 2 * D_SGU
    z, xbc, dt_raw, uv, g_logits = (proj[..., :o1], proj[..., o1:o2], proj[..., o2:o3],
                                    proj[..., o3:o4], proj[..., o4:])
    y_a, h_f, h_b = ssd_bidirectional(z, xbc, dt_raw, h0_f, h0_b, conv_w, conv_b, dt_bias_f,
                                      dt_bias_b, a_log_f, a_log_b, d_skip, ssd_norm_w)
    y_b = chunk_sgu(uv, sgu_ln_g, sgu_ln_b, w_spatial, b_spatial)
    gates = jax.nn.sigmoid(g_logits)
    merged = gates[..., :D_MODEL] * (y_a @ w_proj_a) + gates[..., D_MODEL:] * (y_b @ w_proj_b)
    x = layer_norm(DN_ALPHA * x + gate1 * (merged @ w_out), ln1_g, ln1_b)
    h = x * (1.0 + scale2) + shift2
    f = jnp.square(jax.nn.relu(h @ w_ff1)) @ w_ff2
    x = layer_norm(DN_ALPHA * x + gate2 * f, ln2_g, ln2_b)
    return x, h_f, h_b


def setup_inputs(seed: int = 0) -> dict:
    key = jax.random.key(seed)
    ks = jax.random.split(key, 40)
    f32 = jnp.float32
    nrm = lambda k, shape, scale: jax.random.normal(k, shape, f32) * scale
    L = DEPTH
    dt0 = jnp.exp(jax.random.uniform(ks[10], (L, SSD_HEADS), f32, math.log(1e-3), math.log(1e-1)))
    dt1 = jnp.exp(jax.random.uniform(ks[11], (L, SSD_HEADS), f32, math.log(1e-3), math.log(1e-1)))
    inv_softplus = lambda d: d + jnp.log(-jnp.expm1(-d))
    return {
        'x_prompt': nrm(ks[0], (BATCH, SEQ, D_MODEL), 1.0),
        'x_sample': nrm(ks[1], (DEC_BATCH, DEC_SEQ, D_MODEL), 1.0),
        'state_ssd_fwd': nrm(ks[2], (DEC_BATCH, DEPTH, SSD_HEADS, SSD_HEAD_DIM, SSD_STATE), 0.5),
        'state_ssd_bwd': nrm(ks[3], (DEC_BATCH, DEPTH, SSD_HEADS, SSD_HEAD_DIM, SSD_STATE), 0.5),
        'c': nrm(ks[4], (DEC_BATCH, D_MODEL), 1.0),
        'c_ctx': nrm(ks[5], (D_MODEL,), 1.0),
        'w_ada': nrm(ks[6], (L, D_MODEL, 6 * D_MODEL), 0.5 * D_MODEL ** -0.5),
        'b_ada': nrm(ks[7], (L, 6 * D_MODEL), 0.1),
        'w_in': nrm(ks[8], (L, D_MODEL, D_IN_PROJ), D_MODEL ** -0.5),
        'conv_w': nrm(ks[9], (L, SSD_CONV, SSD_CONV_DIM), SSD_CONV ** -0.5),
        'conv_b': nrm(ks[12], (L, SSD_CONV_DIM), 0.02),
        'dt_bias_fwd': inv_softplus(dt0),
        'dt_bias_bwd': inv_softplus(dt1),
        'a_log_fwd': jnp.log(jax.random.uniform(ks[13], (L, SSD_HEADS), f32, 1.0, 16.0)),
        'a_log_bwd': jnp.log(jax.random.uniform(ks[14], (L, SSD_HEADS), f32, 1.0, 16.0)),
        'd_skip': 1.0 + nrm(ks[15], (L, SSD_HEADS), 0.1),
        'ssd_norm_w': 1.0 + nrm(ks[16], (L, D_SSD), 0.05),
        'sgu_ln_g': 1.0 + nrm(ks[17], (L, D_SGU), 0.05),
        'sgu_ln_b': nrm(ks[18], (L, D_SGU), 0.02),
        'w_spatial': nrm(ks[19], (L, SGU_GROUPS, SGU_CHUNK, SGU_CHUNK), SGU_CHUNK ** -0.5),
        'b_spatial': 1.0 + nrm(ks[20], (L, SGU_GROUPS, SGU_CHUNK), 0.05),
        'w_proj_a': nrm(ks[21], (L, D_SSD, D_MODEL), D_SSD ** -0.5),
        'w_proj_b': nrm(ks[22], (L, D_SGU, D_MODEL), D_SGU ** -0.5),
        'w_out': nrm(ks[23], (L, D_MODEL, D_MODEL), DN_BETA * D_MODEL ** -0.5),
        'ln1_g': 1.0 + nrm(ks[24], (L, D_MODEL), 0.05),
        'ln1_b': nrm(ks[25], (L, D_MODEL), 0.02),
        'w_ff1': nrm(ks[26], (L, D_MODEL, D_FF), D_MODEL ** -0.5),
        'w_ff2': nrm(ks[27], (L, D_FF, D_MODEL), DN_BETA * D_FF ** -0.5),
        'ln2_g': 1.0 + nrm(ks[28], (L, D_MODEL), 0.05),
        'ln2_b': nrm(ks[29], (L, D_MODEL), 0.02),
    }


def reference(x_prompt, x_sample, state_ssd_fwd, state_ssd_bwd, c, c_ctx, w_ada, b_ada, w_in,
              conv_w, conv_b, dt_bias_fwd, dt_bias_bwd, a_log_fwd, a_log_bwd, d_skip, ssd_norm_w,
              sgu_ln_g, sgu_ln_b, w_spatial, b_spatial, w_proj_a, w_proj_b, w_out, ln1_g, ln1_b,
              w_ff1, w_ff2, ln2_g, ln2_b):
    xp = x_prompt
    xs = x_sample + grid_pos_embed(x_sample.shape[1], x_sample.dtype)[None]
    silu_ctx = jax.nn.silu(c_ctx)
    silu_c = jax.nn.silu(c)
    new_f, new_b = [], []
    for l in range(DEPTH):
        p = (w_in[l], conv_w[l], conv_b[l], dt_bias_fwd[l], dt_bias_bwd[l], a_log_fwd[l],
             a_log_bwd[l], d_skip[l], ssd_norm_w[l], sgu_ln_g[l], sgu_ln_b[l], w_spatial[l],
             b_spatial[l], w_proj_a[l], w_proj_b[l], w_out[l], ln1_g[l], ln1_b[l], w_ff1[l],
             w_ff2[l], ln2_g[l], ln2_b[l])
        mod_ctx = (silu_ctx @ w_ada[l] + b_ada[l])[None, None, :]
        h0 = jnp.zeros((xp.shape[0], SSD_HEADS, SSD_HEAD_DIM, SSD_STATE), xp.dtype)
        xp, h_f, h_b = trunk_layer(xp, mod_ctx, h0, h0, *p)
        new_f.append(h_f)
        new_b.append(h_b)
        mod_lat = (silu_c @ w_ada[l] + b_ada[l])[:, None, :]
        xs, _, _ = trunk_layer(xs, mod_lat, state_ssd_fwd[:, l], state_ssd_bwd[:, l], *p)
    new_state_ssd_fwd = jnp.stack(new_f, axis=1)
    new_state_ssd_bwd = jnp.stack(new_b, axis=1)
    return (xp, xs, new_state_ssd_fwd, new_state_ssd_bwd)
```

```cpp
#include <hip/hip_runtime.h>
#include <hip/hip_cooperative_groups.h>
#include <cstdio>
namespace cg = cooperative_groups;
#ifndef MULTI_LAUNCH
#define MULTI_LAUNCH 0
#endif
namespace pg8 {
#define PG8_LAS __attribute__((address_space(3)))
typedef unsigned short bf16_t;
typedef short bf16x8 __attribute__((ext_vector_type(8)));
typedef float f32x4 __attribute__((ext_vector_type(4)));
typedef unsigned u32x4 __attribute__((ext_vector_type(4)));
constexpr int BM = 256, BK = 64, HALF = 128, HTB = HALF * BK * 2  , STAGE_BYTES = 8 * HTB, NXCD = 8, WGM = 8;

__host__ __device__ __forceinline__ int lds_byte(int r, int c) { const int st = (r >> 4) * 2 + (c >> 5), rr = r & 15, cc = c & 31, ob = rr * 64 + cc * 2; return st * 1024 + (ob ^ (((ob >> 9) & 1) << 5)); }
__host__ __device__ __forceinline__ void stage_rc(int b, int& R, int& C) { const int st = b / 1024, sb = b % 1024, swz = sb ^ (((sb >> 9) & 1) << 5); R = (st >> 1) * 16 + swz / 64; C = (st & 1) * 32 + (swz % 64) / 2; }
__host__ __device__ __forceinline__ int perm32(int rho) { const int n = rho >> 4, i = rho & 15; return 8 * (i >> 2) + 4 * n + (i & 3); }

struct Unit { int pm, pn; };
struct Gemm { const bf16_t* A; const bf16_t* Bt; int M, N, K; };

struct StaticOrder {
    int nM, nN, nwg, G, c;
    __host__ __device__ void init(int M, int N, int G_, int c_) { nM = M / BM; nN = N / BM; nwg = nM * nN; G = G_; c = c_; }
    __host__ __device__ bool next(int i, Unit& u) const {
        const long L = (long)i * G + c; if (L >= nwg) return false;
        int wgid = (int)L; { const int q = nwg / NXCD, r = nwg % NXCD, xcd = wgid % NXCD, off = wgid / NXCD; wgid = (xcd < r ? xcd * (q + 1) : r * (q + 1) + (xcd - r) * q) + off; }
        const int nig = WGM * nN, gid = wgid / nig, fm = gid * WGM, gsz = (nM - fm) < WGM ? (nM - fm) : WGM;
        u.pm = fm + ((wgid % nig) % gsz); u.pn = (wgid % nig) / gsz; return true;
    }
    __device__ __forceinline__ void a_ready(const Unit&) const {}
    __device__ __forceinline__ void done(const Unit&) const {}
};
typedef float f32x2 __attribute__((ext_vector_type(2)));
__device__ __forceinline__ f32x2 gelu_pk(f32x2 v) {
    const f32x2 av = __builtin_elementwise_abs(v), d = av * 0.2316418882f + 1.0f;
    f32x2 t; t.x = __builtin_amdgcn_rcpf(d.x); t.y = __builtin_amdgcn_rcpf(d.y);
    f32x2 q = t * 0.5307027145f + (-0.7265760135f); q = q * t + 0.7107068705f; q = q * t + (-0.142248368f); q = q * t + 0.127414796f; q = q * t;
    const f32x2 s = (v * v) * (-0.72134752044f);
    f32x2 e; e.x = __builtin_amdgcn_exp2f(s.x); e.y = __builtin_amdgcn_exp2f(s.y);
    const f32x2 m = v * (q * e), r = v - m;
    f32x2 o; o.x = v.x < 0.f ? m.x : r.x; o.y = v.y < 0.f ? m.y : r.y; return o;
}
template <class Epi, class Sched, bool STAMP = false>
__device__ __forceinline__ void gemm_phase(PG8_LAS unsigned char* lds, const Gemm g, const Sched& S, const Epi& E, unsigned long long* stamps) {
    const int tid = threadIdx.x, wid = __builtin_amdgcn_readfirstlane(tid >> 6), lane = tid & 63, wr = wid >> 2, wc = wid & 3, fr = lane & 15, fq = lane >> 4;
    const int K = g.K, nt = K / BK;
    int ts_lo = 0, ts_hi = 0, nts = 0; const unsigned long long rt_entry = STAMP ? (unsigned long long)wall_clock64() : 0ull;
#define PG8_STAMP() do { if (STAMP && wid == 0 && nts < 64) { const unsigned long long _c = (unsigned long long)clock64(); \
        ts_lo = (lane == nts) ? (int)(unsigned)_c : ts_lo; ts_hi = (lane == nts) ? (int)(unsigned)(_c >> 32) : ts_hi; ++nts; } } while (0)
    PG8_STAMP();
    unsigned voffA[2], voffB[2];
#pragma unroll
    for (int i = 0; i < 2; ++i) { int R, C; stage_rc(tid * 16 + i * 8192, R, C); const int Rb = Epi::PERM ? ((R & ~31) + perm32(R & 31)) : R;
        voffA[i] = (unsigned)(R * K + C) * 2u; voffB[i] = (unsigned)(Rb * K + C) * 2u; }
    const size_t kstep = (size_t)(BK * 2);
    const size_t hstep = (size_t)HALF * K * 2;
    const size_t tstep = 2 * hstep;
    const unsigned ldsw = (unsigned)wid * 1024u;
    const int aoff = lds_byte(wr * 64 + fr, fq * 8), boff = lds_byte(wc * 32 + fr, fq * 8);
#define PG8_SA(b, h) (((b) * 2 + (h)) * HTB)
#define PG8_SB(b, h) ((4 + (b) * 2 + (h)) * HTB)
#define PG8_STAGE(bufoff, gbase, voff) do { _Pragma("unroll") for (int _i = 0; _i < 2; ++_i) \
        __builtin_amdgcn_global_load_lds((const unsigned*)((const char*)(gbase) + (voff)[_i]), (PG8_LAS unsigned*)(lds + (bufoff) + ldsw + _i * 8192), 16, 0, 0); } while (0)
#define PG8_LDA(dst, b, h) do { _Pragma("unroll") for (int m = 0; m < 4; ++m) _Pragma("unroll") for (int k = 0; k < 2; ++k) dst[m][k] = *(const PG8_LAS bf16x8*)(lds + PG8_SA(b, h) + aoff + m * 2048 + k * 1024); } while (0)
#define PG8_LDB(dst, b, h) do { _Pragma("unroll") for (int n = 0; n < 2; ++n) _Pragma("unroll") for (int k = 0; k < 2; ++k) dst[n][k] = *(const PG8_LAS bf16x8*)(lds + PG8_SB(b, h) + boff + n * 2048 + k * 1024); } while (0)
#define PG8_MMA(ai, bj, At, Bt) do { __builtin_amdgcn_s_setprio(1); _Pragma("unroll") for (int m = 0; m < 4; ++m) _Pragma("unroll") for (int n = 0; n < 2; ++n) _Pragma("unroll") for (int k = 0; k < 2; ++k) \
        acc[ai][bj][m][n] = __builtin_amdgcn_mfma_f32_16x16x32_bf16(Bt[n][k], At[m][k], acc[ai][bj][m][n], 0, 0, 0); __builtin_amdgcn_s_setprio(0); } while (0)
#define PG8_WAIT_V(n) asm volatile("s_waitcnt vmcnt(" #n ")" ::: "memory")
#define PG8_WAIT_L(n) asm volatile("s_waitcnt lgkmcnt(" #n ")" ::: "memory")
#define PG8_BAR __builtin_amdgcn_s_barrier()
#define PG8_SCHED __builtin_amdgcn_sched_barrier(0)
    Unit cur, nxt; int ui = 0;
    if (!S.next(0, cur)) return;
    f32x4 acc[2][2][4][2];
#pragma unroll
    for (int a = 0; a < 2; ++a)
#pragma unroll
        for (int b = 0; b < 2; ++b)
#pragma unroll
            for (int m = 0; m < 4; ++m)
#pragma unroll
                for (int n = 0; n < 2; ++n) acc[a][b][m][n] = (f32x4){0.f, 0.f, 0.f, 0.f};
    bf16x8 At[4][2], B0[2][2], B1[2][2];
    const char* cA = (const char*)g.A + (size_t)cur.pm * tstep; const char* cB = (const char*)g.Bt + (size_t)cur.pn * tstep;
    S.a_ready(cur);
    PG8_STAGE(PG8_SB(0, 0), cB, voffB); PG8_STAGE(PG8_SA(0, 0), cA, voffA); PG8_STAGE(PG8_SB(0, 1), cB + hstep, voffB); PG8_STAGE(PG8_SA(0, 1), cA + hstep, voffA);
    if (wr == 1) PG8_BAR;
    PG8_WAIT_V(4); PG8_BAR;
    PG8_STAGE(PG8_SB(1, 0), cB + kstep, voffB); PG8_STAGE(PG8_SA(1, 0), cA + kstep, voffA); PG8_STAGE(PG8_SB(1, 1), cB + hstep + kstep, voffB);
    PG8_WAIT_V(6); PG8_BAR;
    PG8_STAMP();
    for (;;) {
        const bool has_next = S.next(ui + 1, nxt);
        const char* nA = has_next ? (const char*)g.A + (size_t)nxt.pm * tstep : cA; const char* nB = has_next ? (const char*)g.Bt + (size_t)nxt.pn * tstep : cB;
        for (int t = 0; t < nt; t += 2) {
            const bool last = (t == nt - 2);
            const char* a1 = cA + (size_t)(t + 1) * kstep;
            const char* a2 = last ? nA : cA + (size_t)(t + 2) * kstep; const char* b2 = last ? nB : cB + (size_t)(t + 2) * kstep;
            const char* a3 = a2 + kstep; const char* b3 = b2 + kstep;
            if (last && has_next) S.a_ready(nxt);
            PG8_LDB(B0, 0, 0); PG8_SCHED; PG8_LDA(At, 0, 0); PG8_STAGE(PG8_SA(1, 1), a1 + hstep, voffA);
            PG8_WAIT_L(8); PG8_BAR; PG8_WAIT_L(0); PG8_MMA(0, 0, At, B0); PG8_BAR; PG8_SCHED;
            PG8_LDB(B1, 0, 1); PG8_STAGE(PG8_SB(0, 0), b2, voffB);
            PG8_BAR; PG8_WAIT_L(0); PG8_MMA(0, 1, At, B1); PG8_BAR;
            PG8_LDA(At, 0, 1); PG8_STAGE(PG8_SA(0, 0), a2, voffA);
            PG8_BAR; PG8_WAIT_L(0); PG8_MMA(1, 0, At, B0); PG8_BAR; PG8_SCHED;
            PG8_STAGE(PG8_SB(0, 1), b2 + hstep, voffB);
            PG8_WAIT_V(6); PG8_BAR; PG8_MMA(1, 1, At, B1); PG8_BAR;
            PG8_LDB(B0, 1, 0); PG8_SCHED; PG8_LDA(At, 1, 0); PG8_STAGE(PG8_SA(0, 1), a2 + hstep, voffA);
            PG8_WAIT_L(8); PG8_BAR; PG8_WAIT_L(0); PG8_MMA(0, 0, At, B0); PG8_BAR; PG8_SCHED;
            PG8_LDB(B1, 1, 1); PG8_STAGE(PG8_SB(1, 0), b3, voffB);
            PG8_BAR; PG8_WAIT_L(0); PG8_MMA(0, 1, At, B1); PG8_BAR;
            PG8_LDA(At, 1, 1); PG8_STAGE(PG8_SA(1, 0), a3, voffA);
            PG8_BAR; PG8_WAIT_L(0); PG8_MMA(1, 0, At, B0); PG8_BAR; PG8_SCHED;
            PG8_STAGE(PG8_SB(1, 1), b3 + hstep, voffB);
            PG8_WAIT_V(6); PG8_BAR; PG8_MMA(1, 1, At, B1); PG8_BAR;
        }
        PG8_STAMP();
        if constexpr (!Epi::AFTER_DRAIN) { E(acc, cur, wr, wc, fr, fq); S.done(cur); }
        PG8_STAMP();
        if (!has_next) break;
#pragma unroll
        for (int a = 0; a < 2; ++a)
#pragma unroll
            for (int b = 0; b < 2; ++b)
#pragma unroll
                for (int m = 0; m < 4; ++m)
#pragma unroll
                    for (int n = 0; n < 2; ++n) acc[a][b][m][n] = (f32x4){0.f, 0.f, 0.f, 0.f};
        cur = nxt; cA = nA; cB = nB; ++ui;
    }
    PG8_WAIT_V(0);
    if (wr == 0) PG8_BAR;
    PG8_BAR;
    if constexpr (Epi::AFTER_DRAIN) { E.fused(acc, cur, wr, wc, fr, fq, lds, wid, lane); S.done(cur); }
    PG8_STAMP();
    if (STAMP && wid == 0) { stamps[lane] = lane < nts ? (((unsigned long long)(unsigned)ts_hi << 32) | (unsigned)ts_lo) : 0ull;
        if (lane == 62) stamps[62] = rt_entry; if (lane == 63) stamps[63] = (unsigned long long)wall_clock64(); }
#undef PG8_STAMP
#undef PG8_SA
#undef PG8_SB
#undef PG8_STAGE
#undef PG8_LDA
#undef PG8_LDB
#undef PG8_MMA
#undef PG8_WAIT_V
#undef PG8_WAIT_L
#undef PG8_BAR
#undef PG8_SCHED
}
}

#define LAS __attribute__((address_space(3)))
typedef unsigned short bf16_t;
typedef unsigned char uchar;
typedef short bf16x8 __attribute__((ext_vector_type(8)));
typedef float f32x4 __attribute__((ext_vector_type(4)));
typedef float f32x2 __attribute__((ext_vector_type(2)));
typedef float f32x16 __attribute__((ext_vector_type(16)));
typedef unsigned u32x4 __attribute__((ext_vector_type(4)));
typedef unsigned u32x2 __attribute__((ext_vector_type(2)));

constexpr int MT = 12288, DM = 1024, NCTX_TOK = 4096, NCHUNK = 96, NIN = 6912, DFF = 4096;
constexpr float DN_ALPHA = 1.189207115002721f;
constexpr float EPS = 1e-5f;
constexpr int LDS_BYTES = 131072;
constexpr int NTHREADS = 512;

constexpr size_t OFF_WIN = 0;
constexpr size_t OFF_WPA = OFF_WIN + (size_t)NIN * 1024 * 2;
constexpr size_t OFF_WPB = OFF_WPA + 2097152;
constexpr size_t OFF_WOUT = OFF_WPB + 2097152;
constexpr size_t OFF_WFF1 = OFF_WOUT + 2097152;
constexpr size_t OFF_WFF2 = OFF_WFF1 + 8388608;
constexpr size_t OFF_WSP = OFF_WFF2 + 8388608;
constexpr size_t OFF_MODP = OFF_WSP + 262144;
constexpr size_t OFF_MOD = OFF_MODP + 16 * 3 * 6144 * 4;
constexpr size_t OFF_POS = OFF_MOD + 3 * 6144 * 4;
constexpr size_t OFF_DT = OFF_POS + 64 * 512 * 4;
constexpr size_t OFF_VSTAT = OFF_DT + (size_t)MT * 32 * 4;
constexpr size_t OFF_SSQ = OFF_VSTAT + (size_t)MT * 16 * 2 * 4;
constexpr size_t OFF_AL = OFF_SSQ + (size_t)MT * 16 * 4;
constexpr size_t OFF_H1 = OFF_AL + 96 * 16 * 2 * 4;
constexpr size_t OFF_ZS = OFF_H1 + (size_t)MT * 1024 * 2;
constexpr size_t OFF_XBC = OFF_ZS + (size_t)MT * 1024 * 2;
constexpr size_t OFF_V = OFF_XBC + (size_t)MT * 1536 * 2;
constexpr size_t OFF_G = OFF_V + (size_t)MT * 1024 * 2;
constexpr size_t OFF_ST = OFF_G + (size_t)MT * 2048 * 2;
constexpr size_t WS_END = OFF_ST + (size_t)MT * 1024 * 4;
static_assert(WS_END <= 268435456ull, "workspace");
static_assert((size_t)MT * 1024 * 4 <= (size_t)MT * 1536 * 2 + (size_t)MT * 1024 * 2, "R1 fits in XBC+V");

struct Args {
    const float* in[30];
    float* out;
    unsigned char* ws;
    int ph_lo, ph_hi;
};

typedef __bf16 bf16x2_t __attribute__((ext_vector_type(2)));
__device__ __forceinline__ unsigned pk_bf16(float lo, float hi) { bf16x2_t v = {(__bf16)lo, (__bf16)hi}; return __builtin_bit_cast(unsigned, v); }
__device__ __forceinline__ float bf_lo(unsigned u) { return __uint_as_float(u << 16); }
__device__ __forceinline__ float bf_hi(unsigned u) { return __uint_as_float(u & 0xffff0000u); }
__device__ __forceinline__ float bf1(bf16_t b) { return __uint_as_float(((unsigned)b) << 16); }
__device__ __forceinline__ bf16_t to_bf1(float f) { return (bf16_t)(pk_bf16(f, 0.f) & 0xffffu); }
__device__ __forceinline__ float fast_rcp(float x) { return __builtin_amdgcn_rcpf(x); }
__device__ __forceinline__ float sigmoidf_(float v) { return fast_rcp(1.0f + __expf(-v)); }
__device__ __forceinline__ float siluf_(float v) { return v * sigmoidf_(v); }
__device__ __forceinline__ float softplusf_(float v) { return v > 20.f ? v : log1pf(__expf(v)); }
__device__ __forceinline__ float wave_sum(float v) {
#pragma unroll
    for (int o = 1; o < 64; o <<= 1) v += __shfl_xor(v, o);
    return v;
}
__device__ __forceinline__ void unpack8(u32x4 v, float (&o)[8]) {
    o[0] = bf_lo(v.x); o[1] = bf_hi(v.x); o[2] = bf_lo(v.y); o[3] = bf_hi(v.y); o[4] = bf_lo(v.z); o[5] = bf_hi(v.z); o[6] = bf_lo(v.w); o[7] = bf_hi(v.w);
}
__device__ __forceinline__ int mod_idx(int t) { return t < NCTX_TOK ? 0 : 1 + ((t - NCTX_TOK) >> 12); }
__device__ __forceinline__ void seq_bounds(int chunk, int& t0, int& t1) {
    if (chunk < 32) { t0 = (chunk >> 1) * 256; t1 = t0 + 256; } else { t0 = NCTX_TOK + ((chunk - 32) >> 5) * 4096; t1 = t0 + 4096; }
}

using pg8::Unit;
struct EpiIn {
    static constexpr bool PERM = true, AFTER_DRAIN = false;
    bf16_t *ZS, *XBC, *U, *V, *G; float* DT; float* VSTAT; const float *dtbf, *dtbb;
    __device__ __forceinline__ void operator()(const f32x4 (&acc)[2][2][4][2], const Unit& u, int wr, int wc, int fr, int fq) const {
        const int pn = u.pn; const int row0 = u.pm * 256 + wr * 64 + fr;
        if (pn == 26) {
            if (wc == 0) {
                const int c0 = 8 * fq;
                float bias[8];
#pragma unroll
                for (int j = 0; j < 8; ++j) { const int c = c0 + j; bias[j] = c < 16 ? dtbf[c] : dtbb[c - 16]; }
#pragma unroll
                for (int ai = 0; ai < 2; ++ai)
#pragma unroll
                    for (int m = 0; m < 4; ++m) {
                        const int r = row0 + ai * 128 + m * 16; f32x4 o0, o1;
#pragma unroll
                        for (int j = 0; j < 4; ++j) { o0[j] = softplusf_(acc[ai][0][m][0][j] + bias[j]); o1[j] = softplusf_(acc[ai][0][m][1][j] + bias[4 + j]); }
                        *(f32x4*)(DT + (size_t)r * 32 + c0) = o0; *(f32x4*)(DT + (size_t)r * 32 + c0 + 4) = o1;
                    }
            }
            return;
        }
        bf16_t* dst; int ld, cb, act;
        if (pn < 4) { dst = ZS; ld = 1024; cb = pn * 256; act = 1; }
        else if (pn < 10) { dst = XBC; ld = 1536; cb = (pn - 4) * 256; act = 0; }
        else if (pn < 14) { dst = U; ld = 1024; cb = (pn - 10) * 256; act = 2; }
        else if (pn < 18) { dst = V; ld = 1024; cb = (pn - 14) * 256; act = 3; }
        else { dst = G; ld = 2048; cb = (pn - 18) * 256; act = 4; }
        const int col0 = cb + wc * 32 + 8 * fq;
#pragma unroll
        for (int ai = 0; ai < 2; ++ai)
#pragma unroll
            for (int m = 0; m < 4; ++m) {
                const int r = row0 + ai * 128 + m * 16; bf16_t* rowp = dst + (size_t)r * ld + col0;
                float s = 0.f, ss = 0.f;
#pragma unroll
                for (int bj = 0; bj < 2; ++bj) {
                    f32x4 v0 = acc[ai][bj][m][0], v1 = acc[ai][bj][m][1];
                    if (act == 1) {
#pragma unroll
                        for (int j = 0; j < 4; ++j) { v0[j] = siluf_(v0[j]); v1[j] = siluf_(v1[j]); }
                    } else if (act == 2 || act == 3) {
                        f32x2 a = pg8::gelu_pk((f32x2){v0[0], v0[1]}), b = pg8::gelu_pk((f32x2){v0[2], v0[3]}), c = pg8::gelu_pk((f32x2){v1[0], v1[1]}), d = pg8::gelu_pk((f32x2){v1[2], v1[3]});
                        v0 = (f32x4){a.x, a.y, b.x, b.y}; v1 = (f32x4){c.x, c.y, d.x, d.y};
                        if (act == 3) {
#pragma unroll
                            for (int j = 0; j < 4; ++j) { s += v0[j] + v1[j]; ss += v0[j] * v0[j] + v1[j] * v1[j]; }
                        }
                    } else if (act == 4) {
#pragma unroll
                        for (int j = 0; j < 4; ++j) { v0[j] = sigmoidf_(v0[j]); v1[j] = sigmoidf_(v1[j]); }
                    }
                    u32x4 w; w.x = pk_bf16(v0[0], v0[1]); w.y = pk_bf16(v0[2], v0[3]); w.z = pk_bf16(v1[0], v1[1]); w.w = pk_bf16(v1[2], v1[3]);
                    *(u32x4*)(rowp + bj * 128) = w;
                }
                if (act == 3) {
                    s += __shfl_xor(s, 16); s += __shfl_xor(s, 32); ss += __shfl_xor(ss, 16); ss += __shfl_xor(ss, 32);
                    if (fq == 0) *(f32x2*)(VSTAT + ((size_t)r * 16 + (pn - 14) * 4 + wc) * 2) = (f32x2){s, ss};
                }
            }
    }
};
struct EpiPA {
    static constexpr bool PERM = false, AFTER_DRAIN = false;
    float* PA; const bf16_t* G; const float* SSQ;
    __device__ __forceinline__ void operator()(const f32x4 (&acc)[2][2][4][2], const Unit& u, int wr, int wc, int fr, int fq) const {
        const int row0 = u.pm * 256 + wr * 64 + fr, col0 = u.pn * 256 + wc * 32 + 4 * fq;
#pragma unroll
        for (int ai = 0; ai < 2; ++ai)
#pragma unroll
            for (int m = 0; m < 4; ++m) {
                const int r = row0 + ai * 128 + m * 16;
                const f32x4* sq = (const f32x4*)(SSQ + (size_t)r * 16);
                const f32x4 q0 = sq[0], q1 = sq[1], q2 = sq[2], q3 = sq[3];
                const float tot = ((q0[0] + q0[1]) + (q0[2] + q0[3])) + ((q1[0] + q1[1]) + (q1[2] + q1[3])) + ((q2[0] + q2[1]) + (q2[2] + q2[3])) + ((q3[0] + q3[1]) + (q3[2] + q3[3]));
                const float rstd = rsqrtf(tot * (1.0f / 1024.0f) + EPS);
#pragma unroll
                for (int bj = 0; bj < 2; ++bj)
#pragma unroll
                    for (int n = 0; n < 2; ++n) {
                        const int c = col0 + bj * 128 + n * 16;
                        const u32x2 gv = *(const u32x2*)(G + (size_t)r * 2048 + c);
                        f32x4 o = acc[ai][bj][m][n] * rstd;
                        o[0] *= bf_lo(gv.x); o[1] *= bf_hi(gv.x); o[2] *= bf_lo(gv.y); o[3] *= bf_hi(gv.y);
                        *(f32x4*)(PA + (size_t)r * 1024 + c) = o;
                    }
            }
    }
};
struct EpiPB {
    static constexpr bool PERM = false, AFTER_DRAIN = false;
    const float* PA; const bf16_t* G; bf16_t* MB;
    __device__ __forceinline__ void operator()(const f32x4 (&acc)[2][2][4][2], const Unit& u, int wr, int wc, int fr, int fq) const {
        const int row0 = u.pm * 256 + wr * 64 + fr, col0 = u.pn * 256 + wc * 32 + 4 * fq;
#pragma unroll
        for (int ai = 0; ai < 2; ++ai)
#pragma unroll
            for (int m = 0; m < 4; ++m) {
                const int r = row0 + ai * 128 + m * 16;
#pragma unroll
                for (int bj = 0; bj < 2; ++bj)
#pragma unroll
                    for (int n = 0; n < 2; ++n) {
                        const int c = col0 + bj * 128 + n * 16;
                        const u32x2 gv = *(const u32x2*)(G + (size_t)r * 2048 + 1024 + c);
                        f32x4 o = *(const f32x4*)(PA + (size_t)r * 1024 + c); const f32x4 a = acc[ai][bj][m][n];
                        o[0] += a[0] * bf_lo(gv.x); o[1] += a[1] * bf_hi(gv.x); o[2] += a[2] * bf_lo(gv.y); o[3] += a[3] * bf_hi(gv.y);
                        u32x2 w; w.x = pk_bf16(o[0], o[1]); w.y = pk_bf16(o[2], o[3]);
                        *(u32x2*)(MB + (size_t)r * 1024 + c) = w;
                    }
            }
    }
};
struct EpiRes {
    static constexpr bool PERM = false, AFTER_DRAIN = false;
    float* dst; const float* base; const float* xs; const float* POS; const float* gate; int posx;
    __device__ __forceinline__ void operator()(const f32x4 (&acc)[2][2][4][2], const Unit& u, int wr, int wc, int fr, int fq) const {
        const int row0 = u.pm * 256 + wr * 64 + fr, col0 = u.pn * 256 + wc * 32 + 4 * fq;
        const int mi = mod_idx(u.pm * 256); const bool lat = posx && (u.pm * 256 >= NCTX_TOK);
        f32x4 gt[2][2];
#pragma unroll
        for (int bj = 0; bj < 2; ++bj)
#pragma unroll
            for (int n = 0; n < 2; ++n) gt[bj][n] = *(const f32x4*)(gate + (size_t)mi * 6144 + col0 + bj * 128 + n * 16);
#pragma unroll
        for (int ai = 0; ai < 2; ++ai)
#pragma unroll
            for (int m = 0; m < 4; ++m) {
                const int r = row0 + ai * 128 + m * 16;
                const float* bp = lat ? xs + (size_t)(r - NCTX_TOK) * 1024 : base + (size_t)r * 1024;
                const int tt = (r - NCTX_TOK) & 4095;
#pragma unroll
                for (int bj = 0; bj < 2; ++bj)
#pragma unroll
                    for (int n = 0; n < 2; ++n) {
                        const int c = col0 + bj * 128 + n * 16;
                        f32x4 b = *(const f32x4*)(bp + c);
                        if (lat) { const float* pp = c < 512 ? POS + (tt >> 6) * 512 + c : POS + (tt & 63) * 512 + (c - 512); b += *(const f32x4*)pp; }
                        *(f32x4*)(dst + (size_t)r * 1024 + c) = b * DN_ALPHA + gt[bj][n] * acc[ai][bj][m][n];
                    }
            }
    }
};
struct EpiFF1 {
    static constexpr bool PERM = true, AFTER_DRAIN = false;
    bf16_t* FH;
    __device__ __forceinline__ void operator()(const f32x4 (&acc)[2][2][4][2], const Unit& u, int wr, int wc, int fr, int fq) const {
        const int row0 = u.pm * 256 + wr * 64 + fr, col0 = u.pn * 256 + wc * 32 + 8 * fq;
#pragma unroll
        for (int ai = 0; ai < 2; ++ai)
#pragma unroll
            for (int m = 0; m < 4; ++m) {
                bf16_t* rowp = FH + (size_t)(row0 + ai * 128 + m * 16) * DFF + col0;
#pragma unroll
                for (int bj = 0; bj < 2; ++bj) {
                    f32x4 v0 = acc[ai][bj][m][0], v1 = acc[ai][bj][m][1];
#pragma unroll
                    for (int j = 0; j < 4; ++j) { const float a = fmaxf(v0[j], 0.f), b = fmaxf(v1[j], 0.f); v0[j] = a * a; v1[j] = b * b; }
                    u32x4 w; w.x = pk_bf16(v0[0], v0[1]); w.y = pk_bf16(v0[2], v0[3]); w.z = pk_bf16(v1[0], v1[1]); w.w = pk_bf16(v1[2], v1[3]);
                    *(u32x4*)(rowp + bj * 128) = w;
                }
            }
    }
};

struct Ctx {
    const float* in[30]; float* out; uchar* ws; LAS uchar* lds; int tid, lane, wave, G, bid;
};
#define WSP(T, off) ((T*)(C.ws + (off)))

__device__ __forceinline__ void transpose_item(const float* W, int K, int N, bf16_t* WT, int item, int lane, LAS float* scr, bool remap_in) {
    const int nblk = N / 32, kb = item / nblk, nb = item % nblk, k0 = 64 * kb, n0 = 32 * nb;
#pragma unroll 8
    for (int i = 0; i < 32; ++i) { const int kk = 2 * i + (lane >> 5); scr[kk * 33 + (lane & 31)] = W[(size_t)(k0 + kk) * N + n0 + (lane & 31)]; }
    asm volatile("s_waitcnt lgkmcnt(0)" ::: "memory");
    int d0 = n0;
    if (remap_in) d0 = n0 < 2560 ? n0 : (n0 < 2592 ? 6656 + (n0 - 2560) : n0 - 32);
    const int c = lane & 7;
#pragma unroll
    for (int j = 0; j < 4; ++j) { const int n = (lane >> 3) + 8 * j; const LAS float* s = scr + (8 * c) * 33 + n;
        u32x4 o; o.x = pk_bf16(s[0 * 33], s[1 * 33]); o.y = pk_bf16(s[2 * 33], s[3 * 33]); o.z = pk_bf16(s[4 * 33], s[5 * 33]); o.w = pk_bf16(s[6 * 33], s[7 * 33]);
        *(u32x4*)(WT + (size_t)(d0 + n) * K + k0 + 8 * c) = o; }
    asm volatile("s_waitcnt lgkmcnt(0)" ::: "memory");
}
__device__ __forceinline__ void phase0(Ctx& C) {
    {
        LAS float* sv = (LAS float*)C.lds;
        bool have = false;
        for (int it = C.bid; it < 192; it += C.G) {
            if (!have) {
                for (int i = C.tid; i < 3072; i += NTHREADS) { const int m = i >> 10, k = i & 1023; const float v = m == 0 ? C.in[5][k] : C.in[4][(m - 1) * 1024 + k]; sv[i] = siluf_(v); }
                __syncthreads(); have = true;
            }
            const int cgp = it % 12, ks = it / 12, col = cgp * 512 + C.tid;
            const float* w = C.in[6] + (size_t)(ks * 64) * 6144 + col;
            float a0 = 0.f, a1 = 0.f, a2 = 0.f;
#pragma unroll 8
            for (int k = 0; k < 64; ++k) { const float wv = w[(size_t)k * 6144]; const int kk = ks * 64 + k; a0 += sv[kk] * wv; a1 += sv[1024 + kk] * wv; a2 += sv[2048 + kk] * wv; }
            if (ks == 0) { const float b = C.in[7][col]; a0 += b; a1 += b; a2 += b; }
            float* mp = WSP(float, OFF_MODP) + (size_t)ks * 18432 + col;
            mp[0] = a0; mp[6144] = a1; mp[12288] = a2;
        }
        __syncthreads();
    }
    {
        LAS float* scr = (LAS float*)(C.lds + C.wave * 8448);
        const int gw = C.bid * 8 + C.wave, NGW = C.G * 8;
        constexpr int I_IN = 16 * 209, I_SQ = 16 * 32, I_F1 = 16 * 128, I_F2 = 64 * 32;
        constexpr int NIT = I_IN + 3 * I_SQ + I_F1 + I_F2;
        for (int it = gw; it < NIT; it += NGW) {
            int r = it;
            if (r < I_IN) { transpose_item(C.in[8], 1024, 6688, WSP(bf16_t, OFF_WIN), r, C.lane, scr, true); continue; } r -= I_IN;
            if (r < I_SQ) { transpose_item(C.in[21], 1024, 1024, WSP(bf16_t, OFF_WPA), r, C.lane, scr, false); continue; } r -= I_SQ;
            if (r < I_SQ) { transpose_item(C.in[22], 1024, 1024, WSP(bf16_t, OFF_WPB), r, C.lane, scr, false); continue; } r -= I_SQ;
            if (r < I_SQ) { transpose_item(C.in[23], 1024, 1024, WSP(bf16_t, OFF_WOUT), r, C.lane, scr, false); continue; } r -= I_SQ;
            if (r < I_F1) { transpose_item(C.in[26], 1024, 4096, WSP(bf16_t, OFF_WFF1), r, C.lane, scr, false); continue; } r -= I_F1;
            transpose_item(C.in[27], 4096, 1024, WSP(bf16_t, OFF_WFF2), r, C.lane, scr, false);
        }
    }
    const int gt = C.bid * NTHREADS + C.tid, NGT = C.G * NTHREADS;
    { u32x4* p = (u32x4*)(WSP(bf16_t, OFF_WIN) + (size_t)6688 * 1024); for (int i = gt; i < 224 * 1024 / 8; i += NGT) p[i] = (u32x4){0u, 0u, 0u, 0u}; }
    { const f32x4* s = (const f32x4*)C.in[19]; u32x2* d = WSP(u32x2, OFF_WSP); for (int i = gt; i < 131072 / 4; i += NGT) { const f32x4 v = s[i]; d[i] = (u32x2){pk_bf16(v[0], v[1]), pk_bf16(v[2], v[3])}; } }
    { float* P = WSP(float, OFF_POS); for (int i = gt; i < 64 * 512; i += NGT) { const int r = i >> 9, c = i & 511, q = c & 255;
        const float omega = exp2f(-(float)q * (13.287712379549449f / 256.0f)); const float ang = (float)r * omega; P[i] = c < 256 ? sinf(ang) : cosf(ang); } }
}

__device__ __forceinline__ void phase1(Ctx& C) {
    LAS float* ml = (LAS float*)C.lds;
    const float* MODP = WSP(float, OFF_MODP);
    for (int i = C.tid; i < 6144; i += NTHREADS) { const int m = i >> 11, c = i & 2047; float s = 0.f;
#pragma unroll
        for (int ks = 0; ks < 16; ++ks) s += MODP[(size_t)ks * 18432 + m * 6144 + c];
        ml[i] = s; }
    if (C.bid < 36) { const int i = C.bid * 512 + C.tid; float s = 0.f;
#pragma unroll
        for (int ks = 0; ks < 16; ++ks) s += MODP[(size_t)ks * 18432 + i];
        WSP(float, OFF_MOD)[i] = s; }
    __syncthreads();
    const float* POS = WSP(float, OFF_POS); bf16_t* H1 = WSP(bf16_t, OFF_H1);
    const int gw = C.bid * 8 + C.wave, NGW = C.G * 8;
    for (int t = gw; t < MT; t += NGW) {
        const bool lat = t >= NCTX_TOK; const int mi = mod_idx(t), tt = (t - NCTX_TOK) & 4095;
        const float* xr = lat ? C.in[1] + (size_t)(t - NCTX_TOK) * 1024 : C.in[0] + (size_t)t * 1024;
#pragma unroll
        for (int j = 0; j < 4; ++j) { const int c = 4 * C.lane + 256 * j; f32x4 v = *(const f32x4*)(xr + c);
            if (lat) { const float* pp = c < 512 ? POS + (tt >> 6) * 512 + c : POS + (tt & 63) * 512 + (c - 512); v += *(const f32x4*)pp; }
            const f32x4 sh = *(const LAS f32x4*)(ml + mi * 2048 + c), sc = *(const LAS f32x4*)(ml + mi * 2048 + 1024 + c);
            v = v * (sc + 1.0f) + sh;
            *(u32x2*)(H1 + (size_t)t * 1024 + c) = (u32x2){pk_bf16(v[0], v[1]), pk_bf16(v[2], v[3])}; }
    }
}

constexpr int PITCH = 272;
__device__ __forceinline__ int rowmap(int e, int hh) { return (e & 3) + 8 * (e >> 2) + 4 * hh; }
__device__ __forceinline__ f32x16 mma_k128(const LAS uchar* A, const LAS uchar* B, int lane, f32x16 acc) {
    const int r = lane & 31, hh = lane >> 5; const LAS uchar* pa = A + r * PITCH + hh * 16; const LAS uchar* pb = B + r * PITCH + hh * 16;
#pragma unroll
    for (int ks = 0; ks < 8; ++ks) { const bf16x8 a = *(const LAS bf16x8*)(pa + ks * 32); const bf16x8 b = *(const LAS bf16x8*)(pb + ks * 32); acc = __builtin_amdgcn_mfma_f32_32x32x16_bf16(a, b, acc, 0, 0, 0); }
    return acc;
}
__device__ __forceinline__ void conv_silu8(const bf16_t* XBC, const float* cw, const float* cb, int t, int t0, int t1, int ch, float (&o)[8]) {
    const u32x4 z = (u32x4){0u, 0u, 0u, 0u};
    const u32x4 vm = (t - 1 >= t0) ? *(const u32x4*)(XBC + (size_t)(t - 1) * 1536 + ch) : z;
    const u32x4 v0 = *(const u32x4*)(XBC + (size_t)t * 1536 + ch);
    const u32x4 vp = (t + 1 < t1) ? *(const u32x4*)(XBC + (size_t)(t + 1) * 1536 + ch) : z;
    float xm[8], x0[8], xp[8]; unpack8(vm, xm); unpack8(v0, x0); unpack8(vp, xp);
    const f32x4 w0a = *(const f32x4*)(cw + ch), w0b = *(const f32x4*)(cw + ch + 4), w1a = *(const f32x4*)(cw + 1536 + ch), w1b = *(const f32x4*)(cw + 1536 + ch + 4),
                w2a = *(const f32x4*)(cw + 3072 + ch), w2b = *(const f32x4*)(cw + 3072 + ch + 4), ba = *(const f32x4*)(cb + ch), bb = *(const f32x4*)(cb + ch + 4);
#pragma unroll
    for (int e = 0; e < 4; ++e) { o[e] = siluf_(w0a[e] * xm[e] + w1a[e] * x0[e] + w2a[e] * xp[e] + ba[e]); o[4 + e] = siluf_(w0b[e] * xm[4 + e] + w1b[e] * x0[4 + e] + w2b[e] * xp[4 + e] + bb[e]); }
}
__device__ __forceinline__ void chunk_scalars(const float* DT, const float* alf, const float* alb, int tok0, int h, int lane, LAS float* AF, LAS float* AB, LAS float* DF, LAS float* DB, float& totF, float& totB) {
    const int j0 = 2 * lane;
    const float df0 = DT[(size_t)(tok0 + j0) * 32 + h], df1 = DT[(size_t)(tok0 + j0 + 1) * 32 + h], db0 = DT[(size_t)(tok0 + j0) * 32 + 16 + h], db1 = DT[(size_t)(tok0 + j0 + 1) * 32 + 16 + h];
    const float anf = -__expf(alf[h]), anb = -__expf(alb[h]);
    const float f0 = df0 * anf, f1 = df1 * anf, b0 = db0 * anb, b1 = db1 * anb;
    float sf = f0 + f1, sb = b0 + b1;
#pragma unroll
    for (int o = 1; o < 64; o <<= 1) { const float tf = __shfl_up(sf, o), tb = __shfl_up(sb, o); if (lane >= o) { sf += tf; sb += tb; } }
    totF = __shfl(sf, 63); totB = __shfl(sb, 63);
    AF[j0] = sf - f1; AF[j0 + 1] = sf;
    AB[j0] = totB - (sb - b0 - b1); AB[j0 + 1] = totB - (sb - b1);
    DF[j0] = df0; DF[j0 + 1] = df1; DB[j0] = db0; DB[j0 + 1] = db1;
}

__device__ __forceinline__ void ssd_states_item(Ctx& C, int item) {
    const int chunk = item >> 4, h = item & 15, g = h >> 3, tok0 = chunk * 128; int t0, t1; seq_bounds(chunk, t0, t1);
    LAS uchar* BT = C.lds; LAS uchar* XTF = C.lds + 34816; LAS uchar* XTB = C.lds + 52224;
    LAS float* AF = (LAS float*)(C.lds + 69632); LAS float* AB = AF + 128; LAS float* DF = AF + 256; LAS float* DB = AF + 384; LAS float* WF = AF + 512; LAS float* WB = AF + 640;
    const bf16_t* XBC = WSP(bf16_t, OFF_XBC); const float* cw = C.in[9]; const float* cb = C.in[10];
    if (C.wave == 0) {
        float totF, totB; chunk_scalars(WSP(float, OFF_DT), C.in[13], C.in[14], tok0, h, C.lane, AF, AB, DF, DB, totF, totB);
        const int j0 = 2 * C.lane;
        WF[j0] = DF[j0] * __expf(totF - AF[j0]); WF[j0 + 1] = DF[j0 + 1] * __expf(totF - AF[j0 + 1]);
        WB[j0] = DB[j0] * __expf(totB - AB[j0]); WB[j0 + 1] = DB[j0 + 1] * __expf(totB - AB[j0 + 1]);
        if (C.lane == 0) { float* AL = WSP(float, OFF_AL) + (size_t)(chunk * 16 + h) * 2; AL[0] = totF; AL[1] = totB; }
    }
#pragma unroll
    for (int k = 0; k < 2; ++k) { const int u = C.tid + 512 * k, pair = u & 63, oct = u >> 6, ch = 1024 + g * 128 + oct * 8; float y0[8], y1[8];
        conv_silu8(XBC, cw, cb, tok0 + 2 * pair, t0, t1, ch, y0); conv_silu8(XBC, cw, cb, tok0 + 2 * pair + 1, t0, t1, ch, y1);
#pragma unroll
        for (int e = 0; e < 8; ++e) *(LAS unsigned*)(BT + (oct * 8 + e) * PITCH + pair * 4) = pk_bf16(y0[e], y1[e]); }
    __syncthreads();
    { const int pair = C.tid & 63, oct = C.tid >> 6, ch = h * 64 + oct * 8; float y0[8], y1[8];
        conv_silu8(XBC, cw, cb, tok0 + 2 * pair, t0, t1, ch, y0); conv_silu8(XBC, cw, cb, tok0 + 2 * pair + 1, t0, t1, ch, y1);
        const float wf0 = WF[2 * pair], wf1 = WF[2 * pair + 1], wb0 = WB[2 * pair], wb1 = WB[2 * pair + 1];
#pragma unroll
        for (int e = 0; e < 8; ++e) { *(LAS unsigned*)(XTF + (oct * 8 + e) * PITCH + pair * 4) = pk_bf16(y0[e] * wf0, y1[e] * wf1); *(LAS unsigned*)(XTB + (oct * 8 + e) * PITCH + pair * 4) = pk_bf16(y0[e] * wb0, y1[e] * wb1); } }
    __syncthreads();
    { const int dir = C.wave >> 2, tn = C.wave & 3; const LAS uchar* XT = dir ? XTB : XTF;
        f32x16 a0 = {0}, a1 = {0};
        a0 = mma_k128(XT, BT + tn * 32 * PITCH, C.lane, a0); a1 = mma_k128(XT + 32 * PITCH, BT + tn * 32 * PITCH, C.lane, a1);
        bf16_t* ST = WSP(bf16_t, OFF_ST) + ((size_t)(chunk * 16 + h) * 2 + dir) * 8192; const int n = tn * 32 + (C.lane & 31), hh = C.lane >> 5;
#pragma unroll
        for (int e = 0; e < 16; ++e) { const int p = rowmap(e, hh); ST[p * 128 + n] = to_bf1(a0[e]); ST[(32 + p) * 128 + n] = to_bf1(a1[e]); } }
    __syncthreads();
}

__device__ __forceinline__ void sgu_item(Ctx& C, int item) {
    const int chunk = item >> 3, g = item & 7, tok0 = chunk * 128;
    LAS uchar* WS_ = C.lds; LAS uchar* VT = C.lds + 34816; LAS float* MU = (LAS float*)(C.lds + 69632); LAS float* RS = MU + 128;
    if (C.tid < 128) { const f32x4* vs = (const f32x4*)(WSP(float, OFF_VSTAT) + (size_t)(tok0 + C.tid) * 32); float s = 0.f, ss = 0.f;
#pragma unroll
        for (int k = 0; k < 8; ++k) { const f32x4 v = vs[k]; s += v[0] + v[2]; ss += v[1] + v[3]; }
        const float mu = s * (1.0f / 1024.0f), var = fmaxf(ss * (1.0f / 1024.0f) - mu * mu, 0.f); MU[C.tid] = mu; RS[C.tid] = rsqrtf(var + EPS); }
    { const u32x4* src = (const u32x4*)(WSP(bf16_t, OFF_WSP) + (size_t)g * 16384);
#pragma unroll
        for (int k = 0; k < 4; ++k) { const int v = C.tid + 512 * k, i = v >> 4, c8 = v & 15; *(LAS u32x4*)(WS_ + i * PITCH + c8 * 16) = src[v]; } }
    __syncthreads();
    const bf16_t* V = WSP(bf16_t, OFF_V);
#pragma unroll
    for (int k = 0; k < 2; ++k) { const int u = C.tid + 512 * k, pair = u & 63, oct = u >> 6, d0 = g * 128 + oct * 8, ta = tok0 + 2 * pair;
        float va[8], vb[8]; unpack8(*(const u32x4*)(V + (size_t)ta * 1024 + d0), va); unpack8(*(const u32x4*)(V + (size_t)(ta + 1) * 1024 + d0), vb);
        const float mua = MU[2 * pair], rsa = RS[2 * pair], mub = MU[2 * pair + 1], rsb = RS[2 * pair + 1];
        const f32x4 g0 = *(const f32x4*)(C.in[17] + d0), g1 = *(const f32x4*)(C.in[17] + d0 + 4), b0 = *(const f32x4*)(C.in[18] + d0), b1 = *(const f32x4*)(C.in[18] + d0 + 4);
#pragma unroll
        for (int e = 0; e < 8; ++e) { const float gg = e < 4 ? g0[e & 3] : g1[e & 3], bb = e < 4 ? b0[e & 3] : b1[e & 3];
            *(LAS unsigned*)(VT + (oct * 8 + e) * PITCH + pair * 4) = pk_bf16((va[e] - mua) * rsa * gg + bb, (vb[e] - mub) * rsb * gg + bb); } }
    __syncthreads();
    { const int ti = C.wave >> 1, td0 = (C.wave & 1) * 2, hh = C.lane >> 5; bf16_t* U = (bf16_t*)(C.out + 4194304);
#pragma unroll
        for (int q = 0; q < 2; ++q) { f32x16 acc = {0}; acc = mma_k128(WS_ + ti * 32 * PITCH, VT + (td0 + q) * 32 * PITCH, C.lane, acc);
            const int d = g * 128 + (td0 + q) * 32 + (C.lane & 31);
#pragma unroll
            for (int e = 0; e < 16; ++e) { const int i = ti * 32 + rowmap(e, hh); const float s = acc[e] + C.in[20][g * 128 + i]; bf16_t* up = U + (size_t)(tok0 + i) * 1024 + d; *up = to_bf1(bf1(*up) * s); } } }
    __syncthreads();
}

__device__ __forceinline__ void scan_item(Ctx& C, int item) {
    int seq, nc, c0; int r = item;
    if (r < 256) { seq = 16 + (r >> 7); r &= 127; nc = 32; c0 = 32 + (seq - 16) * 32; } else { r -= 256; seq = r >> 7; r &= 127; nc = 2; c0 = seq * 2; }
    const int h = r >> 3, dir = (r >> 2) & 1, quarter = r & 3; const int e0 = quarter * 2048 + C.tid * 4;
    float hv[4];
    if (seq >= 16) { const f32x4 v = *(const f32x4*)((dir ? C.in[3] : C.in[2]) + ((size_t)(seq - 16) * 16 + h) * 8192 + e0); hv[0] = v[0]; hv[1] = v[1]; hv[2] = v[2]; hv[3] = v[3]; } else { hv[0] = hv[1] = hv[2] = hv[3] = 0.f; }
    bf16_t* ST = WSP(bf16_t, OFF_ST); const float* AL = WSP(float, OFF_AL);
    for (int k = 0; k < nc; ++k) { const int c = c0 + (dir ? nc - 1 - k : k);
        u32x2* p = (u32x2*)(ST + ((size_t)(c * 16 + h) * 2 + dir) * 8192 + e0); const u32x2 sv = *p; const float dec = __expf(AL[(size_t)(c * 16 + h) * 2 + dir]);
        *p = (u32x2){pk_bf16(hv[0], hv[1]), pk_bf16(hv[2], hv[3])};
        hv[0] = dec * hv[0] + bf_lo(sv.x); hv[1] = dec * hv[1] + bf_hi(sv.x); hv[2] = dec * hv[2] + bf_lo(sv.y); hv[3] = dec * hv[3] + bf_hi(sv.y); }
    if (seq < 16) *(f32x4*)(C.out + 12582912 + (size_t)dir * 2097152 + ((size_t)seq * 16 + h) * 8192 + e0) = (f32x4){hv[0], hv[1], hv[2], hv[3]};
}

__device__ __forceinline__ void ssd_out_item(Ctx& C, int item) {
    const int chunk = item >> 4, h = item & 15, g = h >> 3, tok0 = chunk * 128; int t0, t1; seq_bounds(chunk, t0, t1);
    LAS uchar* CN = C.lds; LAS uchar* BN = C.lds + 34816; LAS uchar* XT = C.lds + 69632; LAS uchar* HF = C.lds + 87040; LAS uchar* HB = C.lds + 104448;
    LAS float* AF = (LAS float*)(C.lds + 121856); LAS float* AB = AF + 128; LAS float* DF = AF + 256; LAS float* DB = AF + 384; LAS float* SSP = AF + 512;
    const bf16_t* XBC = WSP(bf16_t, OFF_XBC); const float* cw = C.in[9]; const float* cb = C.in[10];
    if (C.wave == 0) { float totF, totB; chunk_scalars(WSP(float, OFF_DT), C.in[13], C.in[14], tok0, h, C.lane, AF, AB, DF, DB, totF, totB); }
#pragma unroll
    for (int k = 0; k < 4; ++k) { const int u = C.tid + 512 * k, oct = u & 15, j = u >> 4; float y[8];
        conv_silu8(XBC, cw, cb, tok0 + j, t0, t1, 1280 + g * 128 + oct * 8, y);
        *(LAS u32x4*)(CN + j * PITCH + oct * 16) = (u32x4){pk_bf16(y[0], y[1]), pk_bf16(y[2], y[3]), pk_bf16(y[4], y[5]), pk_bf16(y[6], y[7])};
        conv_silu8(XBC, cw, cb, tok0 + j, t0, t1, 1024 + g * 128 + oct * 8, y);
        *(LAS u32x4*)(BN + j * PITCH + oct * 16) = (u32x4){pk_bf16(y[0], y[1]), pk_bf16(y[2], y[3]), pk_bf16(y[4], y[5]), pk_bf16(y[6], y[7])}; }
    { const int pair = C.tid & 63, oct = C.tid >> 6, ch = h * 64 + oct * 8; float y0[8], y1[8];
        conv_silu8(XBC, cw, cb, tok0 + 2 * pair, t0, t1, ch, y0); conv_silu8(XBC, cw, cb, tok0 + 2 * pair + 1, t0, t1, ch, y1);
#pragma unroll
        for (int e = 0; e < 8; ++e) *(LAS unsigned*)(XT + (oct * 8 + e) * PITCH + pair * 4) = pk_bf16(y0[e], y1[e]); }
    { const u32x4* hs = (const u32x4*)(WSP(bf16_t, OFF_ST) + (size_t)(chunk * 16 + h) * 2 * 8192);
#pragma unroll
        for (int k = 0; k < 2; ++k) { const int v = C.tid + 512 * k, p = v >> 4, c8 = v & 15; *(LAS u32x4*)(HF + p * PITCH + c8 * 16) = hs[v]; *(LAS u32x4*)(HB + p * PITCH + c8 * 16) = hs[1024 + v]; } }
    __syncthreads();
    const int hh = C.lane >> 5, l31 = C.lane & 31;
    {
        const int ti = C.wave >> 1, tj0 = (C.wave & 1) * 2; f32x16 cbv[2];
#pragma unroll
        for (int q = 0; q < 2; ++q) { cbv[q] = (f32x16){0}; cbv[q] = mma_k128(CN + ti * 32 * PITCH, BN + (tj0 + q) * 32 * PITCH, C.lane, cbv[q]); }
        const float dsk = C.in[15][h];
#pragma unroll
        for (int q = 0; q < 2; ++q) { const int j = (tj0 + q) * 32 + l31; const float afj = AF[j], abj = AB[j], dfj = DF[j], dbj = DB[j];
#pragma unroll
            for (int e = 0; e < 16; ++e) { const int i = ti * 32 + rowmap(e, hh); float w = 0.f;
                if (j <= i) w += __expf(AF[i] - afj) * dfj;
                if (j >= i) w += __expf(AB[i] - abj) * dbj;
                cbv[q][e] = cbv[q][e] * w + (i == j ? dsk : 0.f); } }
        __syncthreads();
#pragma unroll
        for (int q = 0; q < 2; ++q) { const int j = (tj0 + q) * 32 + l31;
#pragma unroll
            for (int e = 0; e < 16; ++e) { const int i = ti * 32 + rowmap(e, hh); *(LAS bf16_t*)(BN + i * PITCH + j * 2) = to_bf1(cbv[q][e]); } }
    }
    __syncthreads();
    {
        const int ti = C.wave >> 1, tp = C.wave & 1; f32x16 ad = {0}, af = {0}, ab = {0};
        ad = mma_k128(BN + ti * 32 * PITCH, XT + tp * 32 * PITCH, C.lane, ad);
        af = mma_k128(CN + ti * 32 * PITCH, HF + tp * 32 * PITCH, C.lane, af);
        ab = mma_k128(CN + ti * 32 * PITCH, HB + tp * 32 * PITCH, C.lane, ab);
        const int p = h * 64 + tp * 32 + l31; const float nw = C.in[16][p]; bf16_t* ZS = WSP(bf16_t, OFF_ZS);
#pragma unroll
        for (int e = 0; e < 16; ++e) { const int i = ti * 32 + rowmap(e, hh); const float y = ad[e] + __expf(AF[i]) * af[e] + __expf(AB[i]) * ab[e];
            bf16_t* zp = ZS + (size_t)(tok0 + i) * 1024 + p; const float gz = y * bf1(*zp); *zp = to_bf1(gz * nw);
            float ss = gz * gz;
#pragma unroll
            for (int o = 1; o < 32; o <<= 1) ss += __shfl_xor(ss, o);
            if (l31 == 0) SSP[i * 2 + tp] = ss; }
    }
    __syncthreads();
    if (C.tid < 128) WSP(float, OFF_SSQ)[(size_t)(tok0 + C.tid) * 16 + h] = SSP[C.tid * 2] + SSP[C.tid * 2 + 1];
    __syncthreads();
}

__device__ __forceinline__ void ln1_pass(Ctx& C) {
    float* R1 = WSP(float, OFF_XBC); bf16_t* H2 = WSP(bf16_t, OFF_ZS); const float* MOD = WSP(float, OFF_MOD);
    const int gw = C.bid * 8 + C.wave, NGW = C.G * 8;
    for (int t = gw; t < MT; t += NGW) { const int mi = mod_idx(t); float* rp = R1 + (size_t)t * 1024; f32x4 v[4]; float s = 0.f;
#pragma unroll
        for (int j = 0; j < 4; ++j) { v[j] = *(const f32x4*)(rp + 4 * C.lane + 256 * j); s += (v[j][0] + v[j][1]) + (v[j][2] + v[j][3]); }
        const float mean = wave_sum(s) * (1.0f / 1024.0f); float q = 0.f;
#pragma unroll
        for (int j = 0; j < 4; ++j) { v[j] = v[j] - mean; q += (v[j][0] * v[j][0] + v[j][1] * v[j][1]) + (v[j][2] * v[j][2] + v[j][3] * v[j][3]); }
        const float rstd = rsqrtf(wave_sum(q) * (1.0f / 1024.0f) + EPS);
#pragma unroll
        for (int j = 0; j < 4; ++j) { const int c = 4 * C.lane + 256 * j; const f32x4 x1 = v[j] * rstd * *(const f32x4*)(C.in[24] + c) + *(const f32x4*)(C.in[25] + c);
            *(f32x4*)(rp + c) = x1;
            const f32x4 hv = x1 * (*(const f32x4*)(MOD + mi * 6144 + 4096 + c) + 1.0f) + *(const f32x4*)(MOD + mi * 6144 + 3072 + c);
            *(u32x2*)(H2 + (size_t)t * 1024 + c) = (u32x2){pk_bf16(hv[0], hv[1]), pk_bf16(hv[2], hv[3])}; }
    }
}
__device__ __forceinline__ void ln2_pass(Ctx& C) {
    const int gw = C.bid * 8 + C.wave, NGW = C.G * 8;
    for (int t = gw; t < MT; t += NGW) { float* rp = C.out + (size_t)t * 1024; f32x4 v[4]; float s = 0.f;
#pragma unroll
        for (int j = 0; j < 4; ++j) { v[j] = *(const f32x4*)(rp + 4 * C.lane + 256 * j); s += (v[j][0] + v[j][1]) + (v[j][2] + v[j][3]); }
        const float mean = wave_sum(s) * (1.0f / 1024.0f); float q = 0.f;
#pragma unroll
        for (int j = 0; j < 4; ++j) { v[j] = v[j] - mean; q += (v[j][0] * v[j][0] + v[j][1] * v[j][1]) + (v[j][2] * v[j][2] + v[j][3] * v[j][3]); }
        const float rstd = rsqrtf(wave_sum(q) * (1.0f / 1024.0f) + EPS);
#pragma unroll
        for (int j = 0; j < 4; ++j) { const int c = 4 * C.lane + 256 * j; *(f32x4*)(rp + c) = v[j] * rstd * *(const f32x4*)(C.in[28] + c) + *(const f32x4*)(C.in[29] + c); }
    }
}

constexpr int NPHASE = 12;
__global__ void __launch_bounds__(NTHREADS, 2) fwd_kernel(Args a) {
    extern __shared__ __attribute__((aligned(16))) unsigned char smem[];
    cg::grid_group grid = cg::this_grid();
    Ctx C;
#pragma unroll
    for (int i = 0; i < 30; ++i) C.in[i] = a.in[i];
    C.out = a.out; C.ws = a.ws; C.lds = (LAS uchar*)smem; C.tid = threadIdx.x; C.lane = C.tid & 63; C.wave = __builtin_amdgcn_readfirstlane(C.tid >> 6); C.G = gridDim.x; C.bid = blockIdx.x;
    const int lo = a.ph_lo, hi = a.ph_hi;
#define IN(k) (lo <= (k) && (k) < hi)
#define SEAM(k) do { if (IN(k) && IN((k) + 1)) grid.sync(); } while (0)
    if (IN(0)) phase0(C);
    SEAM(0);
    if (IN(1)) phase1(C);
    SEAM(1);
    if (IN(2)) {
        pg8::Gemm g{WSP(bf16_t, OFF_H1), WSP(bf16_t, OFF_WIN), MT, NIN, 1024}; pg8::StaticOrder S; S.init(MT, NIN, C.G, C.bid);
        EpiIn E{WSP(bf16_t, OFF_ZS), WSP(bf16_t, OFF_XBC), (bf16_t*)(C.out + 4194304), WSP(bf16_t, OFF_V), WSP(bf16_t, OFF_G), WSP(float, OFF_DT), WSP(float, OFF_VSTAT), C.in[11], C.in[12]};
        pg8::gemm_phase<EpiIn, pg8::StaticOrder, false>(C.lds, g, S, E, nullptr);
    }
    SEAM(2);
    if (IN(3)) { for (int it = C.bid; it < 1536 + 768; it += C.G) { if (it < 1536) ssd_states_item(C, it); else sgu_item(C, it - 1536); } }
    SEAM(3);
    if (IN(4)) { for (int it = C.bid; it < 2304; it += C.G) scan_item(C, it); }
    SEAM(4);
    if (IN(5)) { for (int it = C.bid; it < 1536; it += C.G) ssd_out_item(C, it); }
    SEAM(5);
    if (IN(6)) {
        { pg8::Gemm g{WSP(bf16_t, OFF_ZS), WSP(bf16_t, OFF_WPA), MT, 1024, 1024}; pg8::StaticOrder S; S.init(MT, 1024, C.G, C.bid);
          EpiPA E{WSP(float, OFF_ST), WSP(bf16_t, OFF_G), WSP(float, OFF_SSQ)};
          pg8::gemm_phase<EpiPA, pg8::StaticOrder, false>(C.lds, g, S, E, nullptr); }
        __syncthreads();
        { pg8::Gemm g{(const bf16_t*)(C.out + 4194304), WSP(bf16_t, OFF_WPB), MT, 1024, 1024}; pg8::StaticOrder S; S.init(MT, 1024, C.G, C.bid);
          EpiPB E{WSP(float, OFF_ST), WSP(bf16_t, OFF_G), WSP(bf16_t, OFF_H1)};
          pg8::gemm_phase<EpiPB, pg8::StaticOrder, false>(C.lds, g, S, E, nullptr); }
    }
    SEAM(6);
    if (IN(7)) {
        pg8::Gemm g{WSP(bf16_t, OFF_H1), WSP(bf16_t, OFF_WOUT), MT, 1024, 1024}; pg8::StaticOrder S; S.init(MT, 1024, C.G, C.bid);
        EpiRes E{WSP(float, OFF_XBC), C.in[0], C.in[1], WSP(float, OFF_POS), WSP(float, OFF_MOD) + 2048, 1};
        pg8::gemm_phase<EpiRes, pg8::StaticOrder, false>(C.lds, g, S, E, nullptr);
    }
    SEAM(7);
    if (IN(8)) ln1_pass(C);
    SEAM(8);
    if (IN(9)) {
        pg8::Gemm g{WSP(bf16_t, OFF_ZS), WSP(bf16_t, OFF_WFF1), MT, DFF, 1024}; pg8::StaticOrder S; S.init(MT, DFF, C.G, C.bid);
        EpiFF1 E{WSP(bf16_t, OFF_G)};
        pg8::gemm_phase<EpiFF1, pg8::StaticOrder, false>(C.lds, g, S, E, nullptr);
    }
    SEAM(9);
    if (IN(10)) {
        pg8::Gemm g{WSP(bf16_t, OFF_G), WSP(bf16_t, OFF_WFF2), MT, 1024, DFF}; pg8::StaticOrder S; S.init(MT, 1024, C.G, C.bid);
        EpiRes E{C.out, WSP(float, OFF_XBC), nullptr, nullptr, WSP(float, OFF_MOD) + 5120, 0};
        pg8::gemm_phase<EpiRes, pg8::StaticOrder, false>(C.lds, g, S, E, nullptr);
    }
    SEAM(10);
    if (IN(11)) ln2_pass(C);
#undef IN
#undef SEAM
}

extern "C" void kernel_launch(void* const* d_in, const int* in_sizes, int n_in, void* d_out, int out_size, void* d_ws, size_t ws_size, hipStream_t stream) {
    static int grid = 0;
    if (grid == 0) {
        if (n_in != 30 || out_size != 16777216 || ws_size < WS_END) { fprintf(stderr, "kernel_launch: unexpected shapes (n_in %d out %d ws %zu)\n", n_in, out_size, ws_size); grid = -1; return; }
        int dev = 0, cus = 0, per_cu = 0;
        (void)hipGetDevice(&dev); (void)hipDeviceGetAttribute(&cus, hipDeviceAttributeMultiprocessorCount, dev);
        if (hipFuncSetAttribute((const void*)fwd_kernel, hipFuncAttributeMaxDynamicSharedMemorySize, LDS_BYTES) != hipSuccess) { fprintf(stderr, "hipFuncSetAttribute failed\n"); grid = -1; return; }
        if (hipOccupancyMaxActiveBlocksPerMultiprocessor(&per_cu, (const void*)fwd_kernel, NTHREADS, LDS_BYTES) != hipSuccess || per_cu < 1) per_cu = 1;
        (void)hipGetLastError();
        grid = cus > 0 ? cus : 256;
    }
    if (grid < 0) return;
    Args a{};
    for (int i = 0; i < 30; ++i) a.in[i] = (const float*)d_in[i];
    a.out = (float*)d_out; a.ws = (unsigned char*)d_ws;
#if MULTI_LAUNCH
    for (int ph = 0; ph < NPHASE; ++ph) { a.ph_lo = ph; a.ph_hi = ph + 1; hipLaunchKernelGGL(fwd_kernel, dim3(grid), dim3(NTHREADS), LDS_BYTES, stream, a); }
#else
    a.ph_lo = 0; a.ph_hi = NPHASE;
    void* args[] = {&a};
    hipError_t e = hipLaunchCooperativeKernel((const void*)fwd_kernel, dim3(grid), dim3(NTHREADS), args, LDS_BYTES, stream);
    if (e != hipSuccess) fprintf(stderr, "cooperative launch failed: %s (grid %d)\n", hipGetErrorString(e), grid);
#endif
}
```

```cpp
#include <hip/hip_runtime.h>
#include <hip/hip_cooperative_groups.h>
#include <cstdio>
namespace cg = cooperative_groups;
#ifndef DUP
#define DUP 0
#endif
#ifndef MULTI_LAUNCH
#define MULTI_LAUNCH 0
#endif
namespace pg8 {
#define PG8_LAS __attribute__((address_space(3)))
typedef unsigned short bf16_t;
typedef short bf16x8 __attribute__((ext_vector_type(8)));
typedef float f32x4 __attribute__((ext_vector_type(4)));
typedef unsigned u32x4 __attribute__((ext_vector_type(4)));
constexpr int BM = 256, BK = 64, HALF = 128, HTB = HALF * BK * 2  , STAGE_BYTES = 8 * HTB, NXCD = 8, WGM = 8;

__host__ __device__ __forceinline__ int lds_byte(int r, int c) { const int st = (r >> 4) * 2 + (c >> 5), rr = r & 15, cc = c & 31, ob = rr * 64 + cc * 2; return st * 1024 + (ob ^ (((ob >> 9) & 1) << 5)); }
__host__ __device__ __forceinline__ void stage_rc(int b, int& R, int& C) { const int st = b / 1024, sb = b % 1024, swz = sb ^ (((sb >> 9) & 1) << 5); R = (st >> 1) * 16 + swz / 64; C = (st & 1) * 32 + (swz % 64) / 2; }
__host__ __device__ __forceinline__ int perm32(int rho) { const int n = rho >> 4, i = rho & 15; return 8 * (i >> 2) + 4 * n + (i & 3); }

struct Unit { int pm, pn; };
struct Gemm { const bf16_t* A; const bf16_t* Bt; int M, N, K; };

struct StaticOrder {
    int nM, nN, nwg, G, c;
    __host__ __device__ void init(int M, int N, int G_, int c_) { nM = M / BM; nN = N / BM; nwg = nM * nN; G = G_; c = c_; }
    __host__ __device__ bool next(int i, Unit& u) const {
        const long L = (long)i * G + c; if (L >= nwg) return false;
        int wgid = (int)L; { const int q = nwg / NXCD, r = nwg % NXCD, xcd = wgid % NXCD, off = wgid / NXCD; wgid = (xcd < r ? xcd * (q + 1) : r * (q + 1) + (xcd - r) * q) + off; }
        const int nig = WGM * nN, gid = wgid / nig, fm = gid * WGM, gsz = (nM - fm) < WGM ? (nM - fm) : WGM;
        u.pm = fm + ((wgid % nig) % gsz); u.pn = (wgid % nig) / gsz; return true;
    }
    __device__ __forceinline__ void a_ready(const Unit&) const {}
    __device__ __forceinline__ void done(const Unit&) const {}
};
typedef float f32x2 __attribute__((ext_vector_type(2)));
__device__ __forceinline__ f32x2 gelu_pk(f32x2 v) {
    const f32x2 av = __builtin_elementwise_abs(v), d = av * 0.2316418882f + 1.0f;
    f32x2 t; t.x = __builtin_amdgcn_rcpf(d.x); t.y = __builtin_amdgcn_rcpf(d.y);
    f32x2 q = t * 0.5307027145f + (-0.7265760135f); q = q * t + 0.7107068705f; q = q * t + (-0.142248368f); q = q * t + 0.127414796f; q = q * t;
    const f32x2 s = (v * v) * (-0.72134752044f);
    f32x2 e; e.x = __builtin_amdgcn_exp2f(s.x); e.y = __builtin_amdgcn_exp2f(s.y);
    const f32x2 m = v * (q * e), r = v - m;
    f32x2 o; o.x = v.x < 0.f ? m.x : r.x; o.y = v.y < 0.f ? m.y : r.y; return o;
}
template <class Epi, class Sched, bool STAMP = false>
__device__ __forceinline__ void gemm_phase(PG8_LAS unsigned char* lds, const Gemm g, const Sched& S, const Epi& E, unsigned long long* stamps) {
    const int tid = threadIdx.x, wid = __builtin_amdgcn_readfirstlane(tid >> 6), lane = tid & 63, wr = wid >> 2, wc = wid & 3, fr = lane & 15, fq = lane >> 4;
    const int K = g.K, nt = K / BK;
    int ts_lo = 0, ts_hi = 0, nts = 0; const unsigned long long rt_entry = STAMP ? (unsigned long long)wall_clock64() : 0ull;
#define PG8_STAMP() do { if (STAMP && wid == 0 && nts < 64) { const unsigned long long _c = (unsigned long long)clock64(); \
        ts_lo = (lane == nts) ? (int)(unsigned)_c : ts_lo; ts_hi = (lane == nts) ? (int)(unsigned)(_c >> 32) : ts_hi; ++nts; } } while (0)
    PG8_STAMP();
    unsigned voffA[2], voffB[2];
#pragma unroll
    for (int i = 0; i < 2; ++i) { int R, C; stage_rc(tid * 16 + i * 8192, R, C); const int Rb = Epi::PERM ? ((R & ~31) + perm32(R & 31)) : R;
        voffA[i] = (unsigned)(R * K + C) * 2u; voffB[i] = (unsigned)(Rb * K + C) * 2u; }
    const size_t kstep = (size_t)(BK * 2);
    const size_t hstep = (size_t)HALF * K * 2;
    const size_t tstep = 2 * hstep;
    const unsigned ldsw = (unsigned)wid * 1024u;
    const int aoff = lds_byte(wr * 64 + fr, fq * 8), boff = lds_byte(wc * 32 + fr, fq * 8);
#define PG8_SA(b, h) (((b) * 2 + (h)) * HTB)
#define PG8_SB(b, h) ((4 + (b) * 2 + (h)) * HTB)
#define PG8_STAGE(bufoff, gbase, voff) do { _Pragma("unroll") for (int _i = 0; _i < 2; ++_i) \
        __builtin_amdgcn_global_load_lds((const unsigned*)((const char*)(gbase) + (voff)[_i]), (PG8_LAS unsigned*)(lds + (bufoff) + ldsw + _i * 8192), 16, 0, 0); } while (0)
#define PG8_LDA(dst, b, h) do { _Pragma("unroll") for (int m = 0; m < 4; ++m) _Pragma("unroll") for (int k = 0; k < 2; ++k) dst[m][k] = *(const PG8_LAS bf16x8*)(lds + PG8_SA(b, h) + aoff + m * 2048 + k * 1024); } while (0)
#define PG8_LDB(dst, b, h) do { _Pragma("unroll") for (int n = 0; n < 2; ++n) _Pragma("unroll") for (int k = 0; k < 2; ++k) dst[n][k] = *(const PG8_LAS bf16x8*)(lds + PG8_SB(b, h) + boff + n * 2048 + k * 1024); } while (0)
#define PG8_MMA(ai, bj, At, Bt) do { __builtin_amdgcn_s_setprio(1); _Pragma("unroll") for (int m = 0; m < 4; ++m) _Pragma("unroll") for (int n = 0; n < 2; ++n) _Pragma("unroll") for (int k = 0; k < 2; ++k) \
        acc[ai][bj][m][n] = __builtin_amdgcn_mfma_f32_16x16x32_bf16(Bt[n][k], At[m][k], acc[ai][bj][m][n], 0, 0, 0); __builtin_amdgcn_s_setprio(0); } while (0)
#define PG8_WAIT_V(n) asm volatile("s_waitcnt vmcnt(" #n ")" ::: "memory")
#define PG8_WAIT_L(n) asm volatile("s_waitcnt lgkmcnt(" #n ")" ::: "memory")
#define PG8_BAR __builtin_amdgcn_s_barrier()
#define PG8_SCHED __builtin_amdgcn_sched_barrier(0)
    Unit cur, nxt; int ui = 0;
    if (!S.next(0, cur)) return;
    f32x4 acc[2][2][4][2];
#pragma unroll
    for (int a = 0; a < 2; ++a)
#pragma unroll
        for (int b = 0; b < 2; ++b)
#pragma unroll
            for (int m = 0; m < 4; ++m)
#pragma unroll
                for (int n = 0; n < 2; ++n) acc[a][b][m][n] = (f32x4){0.f, 0.f, 0.f, 0.f};
    bf16x8 At[4][2], B0[2][2], B1[2][2];
    const char* cA = (const char*)g.A + (size_t)cur.pm * tstep; const char* cB = (const char*)g.Bt + (size_t)cur.pn * tstep;
    S.a_ready(cur);
    PG8_STAGE(PG8_SB(0, 0), cB, voffB); PG8_STAGE(PG8_SA(0, 0), cA, voffA); PG8_STAGE(PG8_SB(0, 1), cB + hstep, voffB); PG8_STAGE(PG8_SA(0, 1), cA + hstep, voffA);
    if (wr == 1) PG8_BAR;
    PG8_WAIT_V(4); PG8_BAR;
    PG8_STAGE(PG8_SB(1, 0), cB + kstep, voffB); PG8_STAGE(PG8_SA(1, 0), cA + kstep, voffA); PG8_STAGE(PG8_SB(1, 1), cB + hstep + kstep, voffB);
    PG8_WAIT_V(6); PG8_BAR;
    PG8_STAMP();
    for (;;) {
        const bool has_next = S.next(ui + 1, nxt);
        const char* nA = has_next ? (const char*)g.A + (size_t)nxt.pm * tstep : cA; const char* nB = has_next ? (const char*)g.Bt + (size_t)nxt.pn * tstep : cB;
        for (int t = 0; t < nt; t += 2) {
            const bool last = (t == nt - 2);
            const char* a1 = cA + (size_t)(t + 1) * kstep;
            const char* a2 = last ? nA : cA + (size_t)(t + 2) * kstep; const char* b2 = last ? nB : cB + (size_t)(t + 2) * kstep;
            const char* a3 = a2 + kstep; const char* b3 = b2 + kstep;
            if (last && has_next) S.a_ready(nxt);
            PG8_LDB(B0, 0, 0); PG8_SCHED; PG8_LDA(At, 0, 0); PG8_STAGE(PG8_SA(1, 1), a1 + hstep, voffA);
            PG8_WAIT_L(8); PG8_BAR; PG8_WAIT_L(0); PG8_MMA(0, 0, At, B0); PG8_BAR; PG8_SCHED;
            PG8_LDB(B1, 0, 1); PG8_STAGE(PG8_SB(0, 0), b2, voffB);
            PG8_BAR; PG8_WAIT_L(0); PG8_MMA(0, 1, At, B1); PG8_BAR;
            PG8_LDA(At, 0, 1); PG8_STAGE(PG8_SA(0, 0), a2, voffA);
            PG8_BAR; PG8_WAIT_L(0); PG8_MMA(1, 0, At, B0); PG8_BAR; PG8_SCHED;
            PG8_STAGE(PG8_SB(0, 1), b2 + hstep, voffB);
            PG8_WAIT_V(6); PG8_BAR; PG8_MMA(1, 1, At, B1); PG8_BAR;
            PG8_LDB(B0, 1, 0); PG8_SCHED; PG8_LDA(At, 1, 0); PG8_STAGE(PG8_SA(0, 1), a2 + hstep, voffA);
            PG8_WAIT_L(8); PG8_BAR; PG8_WAIT_L(0); PG8_MMA(0, 0, At, B0); PG8_BAR; PG8_SCHED;
            PG8_LDB(B1, 1, 1); PG8_STAGE(PG8_SB(1, 0), b3, voffB);
            PG8_BAR; PG8_WAIT_L(0); PG8_MMA(0, 1, At, B1); PG8_BAR;
            PG8_LDA(At, 1, 1); PG8_STAGE(PG8_SA(1, 0), a3, voffA);
            PG8_BAR; PG8_WAIT_L(0); PG8_MMA(1, 0, At, B0); PG8_BAR; PG8_SCHED;
            PG8_STAGE(PG8_SB(1, 1), b3 + hstep, voffB);
            PG8_WAIT_V(6); PG8_BAR; PG8_MMA(1, 1, At, B1); PG8_BAR;
        }
        PG8_STAMP();
        if constexpr (!Epi::AFTER_DRAIN) { E(acc, cur, wr, wc, fr, fq); S.done(cur); }
        PG8_STAMP();
        if (!has_next) break;
#pragma unroll
        for (int a = 0; a < 2; ++a)
#pragma unroll
            for (int b = 0; b < 2; ++b)
#pragma unroll
                for (int m = 0; m < 4; ++m)
#pragma unroll
                    for (int n = 0; n < 2; ++n) acc[a][b][m][n] = (f32x4){0.f, 0.f, 0.f, 0.f};
        cur = nxt; cA = nA; cB = nB; ++ui;
    }
    PG8_WAIT_V(0);
    if (wr == 0) PG8_BAR;
    PG8_BAR;
    if constexpr (Epi::AFTER_DRAIN) { E.fused(acc, cur, wr, wc, fr, fq, lds, wid, lane); S.done(cur); }
    PG8_STAMP();
    if (STAMP && wid == 0) { stamps[lane] = lane < nts ? (((unsigned long long)(unsigned)ts_hi << 32) | (unsigned)ts_lo) : 0ull;
        if (lane == 62) stamps[62] = rt_entry; if (lane == 63) stamps[63] = (unsigned long long)wall_clock64(); }
#undef PG8_STAMP
#undef PG8_SA
#undef PG8_SB
#undef PG8_STAGE
#undef PG8_LDA
#undef PG8_LDB
#undef PG8_MMA
#undef PG8_WAIT_V
#undef PG8_WAIT_L
#undef PG8_BAR
#undef PG8_SCHED
}
}

#define LAS __attribute__((address_space(3)))
typedef unsigned short bf16_t;
typedef unsigned char uchar;
typedef short bf16x8 __attribute__((ext_vector_type(8)));
typedef float f32x4 __attribute__((ext_vector_type(4)));
typedef float f32x2 __attribute__((ext_vector_type(2)));
typedef float f32x16 __attribute__((ext_vector_type(16)));
typedef unsigned u32x4 __attribute__((ext_vector_type(4)));
typedef unsigned u32x2 __attribute__((ext_vector_type(2)));

constexpr int MT = 12288, DM = 1024, NCTX_TOK = 4096, NCHUNK = 96, NIN = 6912, DFF = 4096;
constexpr float DN_ALPHA = 1.189207115002721f;
constexpr float EPS = 1e-5f;
constexpr int LDS_BYTES = 131072 + 64;
constexpr int NTHREADS = 512;

constexpr size_t OFF_WIN = 0;
constexpr size_t OFF_WPA = OFF_WIN + (size_t)NIN * 1024 * 2;
constexpr size_t OFF_WPB = OFF_WPA + 2097152;
constexpr size_t OFF_WOUT = OFF_WPB + 2097152;
constexpr size_t OFF_WFF1 = OFF_WOUT + 2097152;
constexpr size_t OFF_WFF2 = OFF_WFF1 + 8388608;
constexpr size_t OFF_WSP = OFF_WFF2 + 8388608;
constexpr size_t OFF_MODP = OFF_WSP + 262144;
constexpr size_t OFF_MOD = OFF_MODP + 16 * 3 * 6144 * 4;
constexpr size_t OFF_POS = OFF_MOD + 3 * 6144 * 4;
constexpr size_t OFF_DT = OFF_POS + 64 * 512 * 4;
constexpr size_t OFF_VSTAT = OFF_DT + (size_t)MT * 32 * 4;
constexpr size_t OFF_SSQ = OFF_VSTAT + (size_t)MT * 16 * 2 * 4;
constexpr size_t OFF_AL = OFF_SSQ + (size_t)MT * 16 * 4;
constexpr size_t OFF_H1 = OFF_AL + 96 * 16 * 2 * 4;
constexpr size_t OFF_ZS = OFF_H1 + (size_t)MT * 1024 * 2;
constexpr size_t OFF_XBC = OFF_ZS + (size_t)MT * 1024 * 2;
constexpr size_t OFF_V = OFF_XBC + (size_t)MT * 1536 * 2;
constexpr size_t OFF_G = OFF_V + (size_t)MT * 1024 * 2;
constexpr size_t OFF_ST = OFF_G + (size_t)MT * 2048 * 2;
constexpr size_t OFF_CTL = OFF_ST + (size_t)MT * 1024 * 4;
constexpr size_t WS_END = OFF_CTL + 16384;
static_assert(WS_END <= 268435456ull, "workspace");
static_assert((size_t)MT * 1024 * 4 <= (size_t)MT * 1536 * 2 + (size_t)MT * 1024 * 2, "R1 fits in XBC+V");

struct Args {
    const float* in[30];
    float* out;
    unsigned char* ws;
    int ph_lo, ph_hi;
};

typedef __bf16 bf16x2_t __attribute__((ext_vector_type(2)));
__device__ __forceinline__ unsigned pk_bf16(float lo, float hi) { bf16x2_t v = {(__bf16)lo, (__bf16)hi}; return __builtin_bit_cast(unsigned, v); }
__device__ __forceinline__ float bf_lo(unsigned u) { return __uint_as_float(u << 16); }
__device__ __forceinline__ float bf_hi(unsigned u) { return __uint_as_float(u & 0xffff0000u); }
__device__ __forceinline__ float bf1(bf16_t b) { return __uint_as_float(((unsigned)b) << 16); }
__device__ __forceinline__ bf16_t to_bf1(float f) { return (bf16_t)(pk_bf16(f, 0.f) & 0xffffu); }
__device__ __forceinline__ float fast_rcp(float x) { return __builtin_amdgcn_rcpf(x); }
__device__ __forceinline__ float sigmoidf_(float v) { return fast_rcp(1.0f + __expf(-v)); }
__device__ __forceinline__ float siluf_(float v) { return v * sigmoidf_(v); }
__device__ __forceinline__ float softplusf_(float v) { return v > 20.f ? v : log1pf(__expf(v)); }
__device__ __forceinline__ float wave_sum(float v) {
#pragma unroll
    for (int o = 1; o < 64; o <<= 1) v += __shfl_xor(v, o);
    return v;
}
__device__ __forceinline__ void unpack8(u32x4 v, float (&o)[8]) {
    o[0] = bf_lo(v.x); o[1] = bf_hi(v.x); o[2] = bf_lo(v.y); o[3] = bf_hi(v.y); o[4] = bf_lo(v.z); o[5] = bf_hi(v.z); o[6] = bf_lo(v.w); o[7] = bf_hi(v.w);
}
__device__ __forceinline__ int mod_idx(int t) { return t < NCTX_TOK ? 0 : 1 + ((t - NCTX_TOK) >> 12); }
__device__ __forceinline__ void seq_bounds(int chunk, int& t0, int& t1) {
    if (chunk < 32) { t0 = (chunk >> 1) * 256; t1 = t0 + 256; } else { t0 = NCTX_TOK + ((chunk - 32) >> 5) * 4096; t1 = t0 + 4096; }
}

using pg8::Unit;
struct EpiIn {
    static constexpr bool PERM = true, AFTER_DRAIN = false;
    bf16_t *ZS, *XBC, *U, *V, *G; float* DT; float* VSTAT; const float *dtbf, *dtbb;
    __device__ __forceinline__ void operator()(const f32x4 (&acc)[2][2][4][2], const Unit& u, int wr, int wc, int fr, int fq) const {
        const int pn = u.pn; const int row0 = u.pm * 256 + wr * 64 + fr;
        if (pn == 26) {
            if (wc == 0) {
                const int c0 = 8 * fq;
                float bias[8];
#pragma unroll
                for (int j = 0; j < 8; ++j) { const int c = c0 + j; bias[j] = c < 16 ? dtbf[c] : dtbb[c - 16]; }
#pragma unroll
                for (int ai = 0; ai < 2; ++ai)
#pragma unroll
                    for (int m = 0; m < 4; ++m) {
                        const int r = row0 + ai * 128 + m * 16; f32x4 o0, o1;
#pragma unroll
                        for (int j = 0; j < 4; ++j) { o0[j] = softplusf_(acc[ai][0][m][0][j] + bias[j]); o1[j] = softplusf_(acc[ai][0][m][1][j] + bias[4 + j]); }
                        *(f32x4*)(DT + (size_t)r * 32 + c0) = o0; *(f32x4*)(DT + (size_t)r * 32 + c0 + 4) = o1;
                    }
            }
            return;
        }
        bf16_t* dst; int ld, cb, act;
        if (pn < 4) { dst = ZS; ld = 1024; cb = pn * 256; act = 1; }
        else if (pn < 10) { dst = XBC; ld = 1536; cb = (pn - 4) * 256; act = 0; }
        else if (pn < 14) { dst = U; ld = 1024; cb = (pn - 10) * 256; act = 2; }
        else if (pn < 18) { dst = V; ld = 1024; cb = (pn - 14) * 256; act = 3; }
        else { dst = G; ld = 2048; cb = (pn - 18) * 256; act = 4; }
        const int col0 = cb + wc * 32 + 8 * fq;
#pragma unroll
        for (int ai = 0; ai < 2; ++ai)
#pragma unroll
            for (int m = 0; m < 4; ++m) {
                const int r = row0 + ai * 128 + m * 16; bf16_t* rowp = dst + (size_t)r * ld + col0;
                float s = 0.f, ss = 0.f;
#pragma unroll
                for (int bj = 0; bj < 2; ++bj) {
                    f32x4 v0 = acc[ai][bj][m][0], v1 = acc[ai][bj][m][1];
                    if (act == 1) {
#pragma unroll
                        for (int j = 0; j < 4; ++j) { v0[j] = siluf_(v0[j]); v1[j] = siluf_(v1[j]); }
                    } else if (act == 2 || act == 3) {
                        f32x2 a = pg8::gelu_pk((f32x2){v0[0], v0[1]}), b = pg8::gelu_pk((f32x2){v0[2], v0[3]}), c = pg8::gelu_pk((f32x2){v1[0], v1[1]}), d = pg8::gelu_pk((f32x2){v1[2], v1[3]});
                        v0 = (f32x4){a.x, a.y, b.x, b.y}; v1 = (f32x4){c.x, c.y, d.x, d.y};
                        if (act == 3) {
#pragma unroll
                            for (int j = 0; j < 4; ++j) { s += v0[j] + v1[j]; ss += v0[j] * v0[j] + v1[j] * v1[j]; }
                        }
                    } else if (act == 4) {
#pragma unroll
                        for (int j = 0; j < 4; ++j) { v0[j] = sigmoidf_(v0[j]); v1[j] = sigmoidf_(v1[j]); }
                    }
                    u32x4 w; w.x = pk_bf16(v0[0], v0[1]); w.y = pk_bf16(v0[2], v0[3]); w.z = pk_bf16(v1[0], v1[1]); w.w = pk_bf16(v1[2], v1[3]);
                    *(u32x4*)(rowp + bj * 128) = w;
                }
                if (act == 3) {
                    s += __shfl_xor(s, 16); s += __shfl_xor(s, 32); ss += __shfl_xor(ss, 16); ss += __shfl_xor(ss, 32);
                    if (fq == 0) *(f32x2*)(VSTAT + ((size_t)r * 16 + (pn - 14) * 4 + wc) * 2) = (f32x2){s, ss};
                }
            }
    }
};
struct EpiPA {
    static constexpr bool PERM = false, AFTER_DRAIN = false;
    float* PA; const bf16_t* G; const float* SSQ;
    __device__ __forceinline__ void operator()(const f32x4 (&acc)[2][2][4][2], const Unit& u, int wr, int wc, int fr, int fq) const {
        const int row0 = u.pm * 256 + wr * 64 + fr, col0 = u.pn * 256 + wc * 32 + 4 * fq;
#pragma unroll
        for (int ai = 0; ai < 2; ++ai)
#pragma unroll
            for (int m = 0; m < 4; ++m) {
                const int r = row0 + ai * 128 + m * 16;
                const f32x4* sq = (const f32x4*)(SSQ + (size_t)r * 16);
                const f32x4 q0 = sq[0], q1 = sq[1], q2 = sq[2], q3 = sq[3];
                const float tot = ((q0[0] + q0[1]) + (q0[2] + q0[3])) + ((q1[0] + q1[1]) + (q1[2] + q1[3])) + ((q2[0] + q2[1]) + (q2[2] + q2[3])) + ((q3[0] + q3[1]) + (q3[2] + q3[3]));
                const float rstd = rsqrtf(tot * (1.0f / 1024.0f) + EPS);
#pragma unroll
                for (int bj = 0; bj < 2; ++bj)
#pragma unroll
                    for (int n = 0; n < 2; ++n) {
                        const int c = col0 + bj * 128 + n * 16;
                        const u32x2 gv = *(const u32x2*)(G + (size_t)r * 2048 + c);
                        f32x4 o = acc[ai][bj][m][n] * rstd;
                        o[0] *= bf_lo(gv.x); o[1] *= bf_hi(gv.x); o[2] *= bf_lo(gv.y); o[3] *= bf_hi(gv.y);
                        *(f32x4*)(PA + (size_t)r * 1024 + c) = o;
                    }
            }
    }
};
struct EpiPB {
    static constexpr bool PERM = false, AFTER_DRAIN = false;
    const float* PA; const bf16_t* G; bf16_t* MB;
    __device__ __forceinline__ void operator()(const f32x4 (&acc)[2][2][4][2], const Unit& u, int wr, int wc, int fr, int fq) const {
        const int row0 = u.pm * 256 + wr * 64 + fr, col0 = u.pn * 256 + wc * 32 + 4 * fq;
#pragma unroll
        for (int ai = 0; ai < 2; ++ai)
#pragma unroll
            for (int m = 0; m < 4; ++m) {
                const int r = row0 + ai * 128 + m * 16;
#pragma unroll
                for (int bj = 0; bj < 2; ++bj)
#pragma unroll
                    for (int n = 0; n < 2; ++n) {
                        const int c = col0 + bj * 128 + n * 16;
                        const u32x2 gv = *(const u32x2*)(G + (size_t)r * 2048 + 1024 + c);
                        f32x4 o = *(const f32x4*)(PA + (size_t)r * 1024 + c); const f32x4 a = acc[ai][bj][m][n];
                        o[0] += a[0] * bf_lo(gv.x); o[1] += a[1] * bf_hi(gv.x); o[2] += a[2] * bf_lo(gv.y); o[3] += a[3] * bf_hi(gv.y);
                        u32x2 w; w.x = pk_bf16(o[0], o[1]); w.y = pk_bf16(o[2], o[3]);
                        *(u32x2*)(MB + (size_t)r * 1024 + c) = w;
                    }
            }
    }
};
struct EpiRes {
    static constexpr bool PERM = false, AFTER_DRAIN = false;
    float* dst; const float* base; const float* xs; const float* POS; const float* gate; int posx;
    __device__ __forceinline__ void operator()(const f32x4 (&acc)[2][2][4][2], const Unit& u, int wr, int wc, int fr, int fq) const {
        const int row0 = u.pm * 256 + wr * 64 + fr, col0 = u.pn * 256 + wc * 32 + 4 * fq;
        const int mi = mod_idx(u.pm * 256); const bool lat = posx && (u.pm * 256 >= NCTX_TOK);
        f32x4 gt[2][2];
#pragma unroll
        for (int bj = 0; bj < 2; ++bj)
#pragma unroll
            for (int n = 0; n < 2; ++n) gt[bj][n] = *(const f32x4*)(gate + (size_t)mi * 6144 + col0 + bj * 128 + n * 16);
#pragma unroll
        for (int ai = 0; ai < 2; ++ai)
#pragma unroll
            for (int m = 0; m < 4; ++m) {
                const int r = row0 + ai * 128 + m * 16;
                const float* bp = lat ? xs + (size_t)(r - NCTX_TOK) * 1024 : base + (size_t)r * 1024;
                const int tt = (r - NCTX_TOK) & 4095;
#pragma unroll
                for (int bj = 0; bj < 2; ++bj)
#pragma unroll
                    for (int n = 0; n < 2; ++n) {
                        const int c = col0 + bj * 128 + n * 16;
                        f32x4 b = *(const f32x4*)(bp + c);
                        if (lat) { const float* pp = c < 512 ? POS + (tt >> 6) * 512 + c : POS + (tt & 63) * 512 + (c - 512); b += *(const f32x4*)pp; }
                        *(f32x4*)(dst + (size_t)r * 1024 + c) = b * DN_ALPHA + gt[bj][n] * acc[ai][bj][m][n];
                    }
            }
    }
};
struct EpiFF1 {
    static constexpr bool PERM = true, AFTER_DRAIN = false;
    bf16_t* FH;
    __device__ __forceinline__ void operator()(const f32x4 (&acc)[2][2][4][2], const Unit& u, int wr, int wc, int fr, int fq) const {
        const int row0 = u.pm * 256 + wr * 64 + fr, col0 = u.pn * 256 + wc * 32 + 8 * fq;
#pragma unroll
        for (int ai = 0; ai < 2; ++ai)
#pragma unroll
            for (int m = 0; m < 4; ++m) {
                bf16_t* rowp = FH + (size_t)(row0 + ai * 128 + m * 16) * DFF + col0;
#pragma unroll
                for (int bj = 0; bj < 2; ++bj) {
                    f32x4 v0 = acc[ai][bj][m][0], v1 = acc[ai][bj][m][1];
#pragma unroll
                    for (int j = 0; j < 4; ++j) { const float a = fmaxf(v0[j], 0.f), b = fmaxf(v1[j], 0.f); v0[j] = a * a; v1[j] = b * b; }
                    u32x4 w; w.x = pk_bf16(v0[0], v0[1]); w.y = pk_bf16(v0[2], v0[3]); w.z = pk_bf16(v1[0], v1[1]); w.w = pk_bf16(v1[2], v1[3]);
                    *(u32x4*)(rowp + bj * 128) = w;
                }
            }
    }
};

struct Ctx {
    const float* in[30]; float* out; uchar* ws; LAS uchar* lds; int tid, lane, wave, G, bid;
};
#define WSP(T, off) ((T*)(C.ws + (off)))

__device__ __forceinline__ void transpose_item(const float* W, int K, int N, bf16_t* WT, int item, int lane, LAS float* scr, bool remap_in) {
    const int nblk = N / 32, kb = item / nblk, nb = item % nblk, k0 = 64 * kb, n0 = 32 * nb;
#pragma unroll 8
    for (int i = 0; i < 32; ++i) { const int kk = 2 * i + (lane >> 5); scr[kk * 33 + (lane & 31)] = W[(size_t)(k0 + kk) * N + n0 + (lane & 31)]; }
    asm volatile("s_waitcnt lgkmcnt(0)" ::: "memory");
    int d0 = n0;
    if (remap_in) d0 = n0 < 2560 ? n0 : (n0 < 2592 ? 6656 + (n0 - 2560) : n0 - 32);
    const int c = lane & 7;
#pragma unroll
    for (int j = 0; j < 4; ++j) { const int n = (lane >> 3) + 8 * j; const LAS float* s = scr + (8 * c) * 33 + n;
        u32x4 o; o.x = pk_bf16(s[0 * 33], s[1 * 33]); o.y = pk_bf16(s[2 * 33], s[3 * 33]); o.z = pk_bf16(s[4 * 33], s[5 * 33]); o.w = pk_bf16(s[6 * 33], s[7 * 33]);
        *(u32x4*)(WT + (size_t)(d0 + n) * K + k0 + 8 * c) = o; }
    asm volatile("s_waitcnt lgkmcnt(0)" ::: "memory");
}
__device__ __forceinline__ void phase0(Ctx& C) {
    {
        LAS float* sv = (LAS float*)C.lds;
        bool have = false;
        for (int it = C.bid; it < 192; it += C.G) {
            if (!have) {
                for (int i = C.tid; i < 3072; i += NTHREADS) { const int m = i >> 10, k = i & 1023; const float v = m == 0 ? C.in[5][k] : C.in[4][(m - 1) * 1024 + k]; sv[i] = siluf_(v); }
                __syncthreads(); have = true;
            }
            const int cgp = it % 12, ks = it / 12, col = cgp * 512 + C.tid;
            const float* w = C.in[6] + (size_t)(ks * 64) * 6144 + col;
            float a0 = 0.f, a1 = 0.f, a2 = 0.f;
#pragma unroll 8
            for (int k = 0; k < 64; ++k) { const float wv = w[(size_t)k * 6144]; const int kk = ks * 64 + k; a0 += sv[kk] * wv; a1 += sv[1024 + kk] * wv; a2 += sv[2048 + kk] * wv; }
            if (ks == 0) { const float b = C.in[7][col]; a0 += b; a1 += b; a2 += b; }
            float* mp = WSP(float, OFF_MODP) + (size_t)ks * 18432 + col;
            mp[0] = a0; mp[6144] = a1; mp[12288] = a2;
        }
        __syncthreads();
    }
    {
        LAS float* scr = (LAS float*)(C.lds + C.wave * 8448);
        const int gw = C.bid * 8 + C.wave, NGW = C.G * 8;
        constexpr int I_IN = 16 * 209, I_SQ = 16 * 32, I_F1 = 16 * 128, I_F2 = 64 * 32;
        constexpr int NIT = I_IN + 3 * I_SQ + I_F1 + I_F2;
        for (int it = gw; it < NIT; it += NGW) {
            int r = it;
            if (r < I_IN) { transpose_item(C.in[8], 1024, 6688, WSP(bf16_t, OFF_WIN), r, C.lane, scr, true); continue; } r -= I_IN;
            if (r < I_SQ) { transpose_item(C.in[21], 1024, 1024, WSP(bf16_t, OFF_WPA), r, C.lane, scr, false); continue; } r -= I_SQ;
            if (r < I_SQ) { transpose_item(C.in[22], 1024, 1024, WSP(bf16_t, OFF_WPB), r, C.lane, scr, false); continue; } r -= I_SQ;
            if (r < I_SQ) { transpose_item(C.in[23], 1024, 1024, WSP(bf16_t, OFF_WOUT), r, C.lane, scr, false); continue; } r -= I_SQ;
            if (r < I_F1) { transpose_item(C.in[26], 1024, 4096, WSP(bf16_t, OFF_WFF1), r, C.lane, scr, false); continue; } r -= I_F1;
            transpose_item(C.in[27], 4096, 1024, WSP(bf16_t, OFF_WFF2), r, C.lane, scr, false);
        }
    }
    const int gt = C.bid * NTHREADS + C.tid, NGT = C.G * NTHREADS;
    { u32x4* p = (u32x4*)(WSP(bf16_t, OFF_WIN) + (size_t)6688 * 1024); for (int i = gt; i < 224 * 1024 / 8; i += NGT) p[i] = (u32x4){0u, 0u, 0u, 0u}; }
    { const f32x4* s = (const f32x4*)C.in[19]; u32x2* d = WSP(u32x2, OFF_WSP); for (int i = gt; i < 131072 / 4; i += NGT) { const f32x4 v = s[i]; d[i] = (u32x2){pk_bf16(v[0], v[1]), pk_bf16(v[2], v[3])}; } }
    { float* P = WSP(float, OFF_POS); for (int i = gt; i < 64 * 512; i += NGT) { const int r = i >> 9, c = i & 511, q = c & 255;
        const float omega = exp2f(-(float)q * (13.287712379549449f / 256.0f)); const float ang = (float)r * omega; P[i] = c < 256 ? sinf(ang) : cosf(ang); } }
}

__device__ __forceinline__ void phase1(Ctx& C) {
    LAS float* ml = (LAS float*)C.lds;
    const float* MODP = WSP(float, OFF_MODP);
    for (int i = C.tid; i < 6144; i += NTHREADS) { const int m = i >> 11, c = i & 2047; float s = 0.f;
#pragma unroll
        for (int ks = 0; ks < 16; ++ks) s += MODP[(size_t)ks * 18432 + m * 6144 + c];
        ml[i] = s; }
    if (C.bid < 36) { const int i = C.bid * 512 + C.tid; float s = 0.f;
#pragma unroll
        for (int ks = 0; ks < 16; ++ks) s += MODP[(size_t)ks * 18432 + i];
        WSP(float, OFF_MOD)[i] = s; }
    __syncthreads();
    const float* POS = WSP(float, OFF_POS); bf16_t* H1 = WSP(bf16_t, OFF_H1);
    const int gw = C.bid * 8 + C.wave, NGW = C.G * 8;
    for (int t = gw; t < MT; t += NGW) {
        const bool lat = t >= NCTX_TOK; const int mi = mod_idx(t), tt = (t - NCTX_TOK) & 4095;
        const float* xr = lat ? C.in[1] + (size_t)(t - NCTX_TOK) * 1024 : C.in[0] + (size_t)t * 1024;
#pragma unroll
        for (int j = 0; j < 4; ++j) { const int c = 4 * C.lane + 256 * j; f32x4 v = *(const f32x4*)(xr + c);
            if (lat) { const float* pp = c < 512 ? POS + (tt >> 6) * 512 + c : POS + (tt & 63) * 512 + (c - 512); v += *(const f32x4*)pp; }
            const f32x4 sh = *(const LAS f32x4*)(ml + mi * 2048 + c), sc = *(const LAS f32x4*)(ml + mi * 2048 + 1024 + c);
            v = v * (sc + 1.0f) + sh;
            *(u32x2*)(H1 + (size_t)t * 1024 + c) = (u32x2){pk_bf16(v[0], v[1]), pk_bf16(v[2], v[3])}; }
    }
}

constexpr int PITCH = 272;
__device__ __forceinline__ int rowmap(int e, int hh) { return (e & 3) + 8 * (e >> 2) + 4 * hh; }
__device__ __forceinline__ f32x16 mma_k128(const LAS uchar* A, const LAS uchar* B, int lane, f32x16 acc) {
    const int r = lane & 31, hh = lane >> 5; const LAS uchar* pa = A + r * PITCH + hh * 16; const LAS uchar* pb = B + r * PITCH + hh * 16;
#pragma unroll
    for (int ks = 0; ks < 8; ++ks) { const bf16x8 a = *(const LAS bf16x8*)(pa + ks * 32); const bf16x8 b = *(const LAS bf16x8*)(pb + ks * 32); acc = __builtin_amdgcn_mfma_f32_32x32x16_bf16(a, b, acc, 0, 0, 0); }
    return acc;
}
__device__ __forceinline__ void conv_silu8(const bf16_t* XBC, const float* cw, const float* cb, int t, int t0, int t1, int ch, float (&o)[8]) {
    const u32x4 z = (u32x4){0u, 0u, 0u, 0u};
    const u32x4 vm = (t - 1 >= t0) ? *(const u32x4*)(XBC + (size_t)(t - 1) * 1536 + ch) : z;
    const u32x4 v0 = *(const u32x4*)(XBC + (size_t)t * 1536 + ch);
    const u32x4 vp = (t + 1 < t1) ? *(const u32x4*)(XBC + (size_t)(t + 1) * 1536 + ch) : z;
    float xm[8], x0[8], xp[8]; unpack8(vm, xm); unpack8(v0, x0); unpack8(vp, xp);
    const f32x4 w0a = *(const f32x4*)(cw + ch), w0b = *(const f32x4*)(cw + ch + 4), w1a = *(const f32x4*)(cw + 1536 + ch), w1b = *(const f32x4*)(cw + 1536 + ch + 4),
                w2a = *(const f32x4*)(cw + 3072 + ch), w2b = *(const f32x4*)(cw + 3072 + ch + 4), ba = *(const f32x4*)(cb + ch), bb = *(const f32x4*)(cb + ch + 4);
#pragma unroll
    for (int e = 0; e < 4; ++e) { o[e] = siluf_(w0a[e] * xm[e] + w1a[e] * x0[e] + w2a[e] * xp[e] + ba[e]); o[4 + e] = siluf_(w0b[e] * xm[4 + e] + w1b[e] * x0[4 + e] + w2b[e] * xp[4 + e] + bb[e]); }
}
__device__ __forceinline__ void chunk_scalars(const float* DT, const float* alf, const float* alb, int tok0, int h, int lane, LAS float* AF, LAS float* AB, LAS float* DF, LAS float* DB, float& totF, float& totB) {
    const int j0 = 2 * lane;
    const float df0 = DT[(size_t)(tok0 + j0) * 32 + h], df1 = DT[(size_t)(tok0 + j0 + 1) * 32 + h], db0 = DT[(size_t)(tok0 + j0) * 32 + 16 + h], db1 = DT[(size_t)(tok0 + j0 + 1) * 32 + 16 + h];
    const float anf = -__expf(alf[h]), anb = -__expf(alb[h]);
    const float f0 = df0 * anf, f1 = df1 * anf, b0 = db0 * anb, b1 = db1 * anb;
    float sf = f0 + f1, sb = b0 + b1;
#pragma unroll
    for (int o = 1; o < 64; o <<= 1) { const float tf = __shfl_up(sf, o), tb = __shfl_up(sb, o); if (lane >= o) { sf += tf; sb += tb; } }
    totF = __shfl(sf, 63); totB = __shfl(sb, 63);
    AF[j0] = sf - f1; AF[j0 + 1] = sf;
    AB[j0] = totB - (sb - b0 - b1); AB[j0 + 1] = totB - (sb - b1);
    DF[j0] = df0; DF[j0 + 1] = df1; DB[j0] = db0; DB[j0 + 1] = db1;
}

__device__ __forceinline__ void ssd_states_item(Ctx& C, int item) {
    const int chunk = item >> 4, h = item & 15, g = h >> 3, tok0 = chunk * 128; int t0, t1; seq_bounds(chunk, t0, t1);
    LAS uchar* BT = C.lds; LAS uchar* XTF = C.lds + 34816; LAS uchar* XTB = C.lds + 52224;
    LAS float* AF = (LAS float*)(C.lds + 69632); LAS float* AB = AF + 128; LAS float* DF = AF + 256; LAS float* DB = AF + 384; LAS float* WF = AF + 512; LAS float* WB = AF + 640;
    const bf16_t* XBC = WSP(bf16_t, OFF_XBC); const float* cw = C.in[9]; const float* cb = C.in[10];
    if (C.wave == 0) {
        float totF, totB; chunk_scalars(WSP(float, OFF_DT), C.in[13], C.in[14], tok0, h, C.lane, AF, AB, DF, DB, totF, totB);
        const int j0 = 2 * C.lane;
        WF[j0] = DF[j0] * __expf(totF - AF[j0]); WF[j0 + 1] = DF[j0 + 1] * __expf(totF - AF[j0 + 1]);
        WB[j0] = DB[j0] * __expf(totB - AB[j0]); WB[j0 + 1] = DB[j0 + 1] * __expf(totB - AB[j0 + 1]);
        if (C.lane == 0) { float* AL = WSP(float, OFF_AL) + (size_t)(chunk * 16 + h) * 2; AL[0] = totF; AL[1] = totB; }
    }
#pragma unroll
    for (int k = 0; k < 2; ++k) { const int u = C.tid + 512 * k, pair = u & 63, oct = u >> 6, ch = 1024 + g * 128 + oct * 8; float y0[8], y1[8];
        conv_silu8(XBC, cw, cb, tok0 + 2 * pair, t0, t1, ch, y0); conv_silu8(XBC, cw, cb, tok0 + 2 * pair + 1, t0, t1, ch, y1);
#pragma unroll
        for (int e = 0; e < 8; ++e) *(LAS unsigned*)(BT + (oct * 8 + e) * PITCH + pair * 4) = pk_bf16(y0[e], y1[e]); }
    __syncthreads();
    { const int pair = C.tid & 63, oct = C.tid >> 6, ch = h * 64 + oct * 8; float y0[8], y1[8];
        conv_silu8(XBC, cw, cb, tok0 + 2 * pair, t0, t1, ch, y0); conv_silu8(XBC, cw, cb, tok0 + 2 * pair + 1, t0, t1, ch, y1);
        const float wf0 = WF[2 * pair], wf1 = WF[2 * pair + 1], wb0 = WB[2 * pair], wb1 = WB[2 * pair + 1];
#pragma unroll
        for (int e = 0; e < 8; ++e) { *(LAS unsigned*)(XTF + (oct * 8 + e) * PITCH + pair * 4) = pk_bf16(y0[e] * wf0, y1[e] * wf1); *(LAS unsigned*)(XTB + (oct * 8 + e) * PITCH + pair * 4) = pk_bf16(y0[e] * wb0, y1[e] * wb1); } }
    __syncthreads();
    { const int dir = C.wave >> 2, tn = C.wave & 3; const LAS uchar* XT = dir ? XTB : XTF;
        f32x16 a0 = {0}, a1 = {0};
        a0 = mma_k128(XT, BT + tn * 32 * PITCH, C.lane, a0); a1 = mma_k128(XT + 32 * PITCH, BT + tn * 32 * PITCH, C.lane, a1);
        bf16_t* ST = WSP(bf16_t, OFF_ST) + ((size_t)(chunk * 16 + h) * 2 + dir) * 8192; const int n = tn * 32 + (C.lane & 31), hh = C.lane >> 5;
#pragma unroll
        for (int e = 0; e < 16; ++e) { const int p = rowmap(e, hh); ST[p * 128 + n] = to_bf1(a0[e]); ST[(32 + p) * 128 + n] = to_bf1(a1[e]); } }
    __syncthreads();
}

__device__ __forceinline__ void sgu_item(Ctx& C, int item) {
    const int chunk = item >> 3, g = item & 7, tok0 = chunk * 128;
    LAS uchar* WS_ = C.lds; LAS uchar* VT = C.lds + 34816; LAS float* MU = (LAS float*)(C.lds + 69632); LAS float* RS = MU + 128;
    if (C.tid < 128) { const f32x4* vs = (const f32x4*)(WSP(float, OFF_VSTAT) + (size_t)(tok0 + C.tid) * 32); float s = 0.f, ss = 0.f;
#pragma unroll
        for (int k = 0; k < 8; ++k) { const f32x4 v = vs[k]; s += v[0] + v[2]; ss += v[1] + v[3]; }
        const float mu = s * (1.0f / 1024.0f), var = fmaxf(ss * (1.0f / 1024.0f) - mu * mu, 0.f); MU[C.tid] = mu; RS[C.tid] = rsqrtf(var + EPS); }
    { const u32x4* src = (const u32x4*)(WSP(bf16_t, OFF_WSP) + (size_t)g * 16384);
#pragma unroll
        for (int k = 0; k < 4; ++k) { const int v = C.tid + 512 * k, i = v >> 4, c8 = v & 15; *(LAS u32x4*)(WS_ + i * PITCH + c8 * 16) = src[v]; } }
    __syncthreads();
    const bf16_t* V = WSP(bf16_t, OFF_V);
#pragma unroll
    for (int k = 0; k < 2; ++k) { const int u = C.tid + 512 * k, pair = u & 63, oct = u >> 6, d0 = g * 128 + oct * 8, ta = tok0 + 2 * pair;
        float va[8], vb[8]; unpack8(*(const u32x4*)(V + (size_t)ta * 1024 + d0), va); unpack8(*(const u32x4*)(V + (size_t)(ta + 1) * 1024 + d0), vb);
        const float mua = MU[2 * pair], rsa = RS[2 * pair], mub = MU[2 * pair + 1], rsb = RS[2 * pair + 1];
        const f32x4 g0 = *(const f32x4*)(C.in[17] + d0), g1 = *(const f32x4*)(C.in[17] + d0 + 4), b0 = *(const f32x4*)(C.in[18] + d0), b1 = *(const f32x4*)(C.in[18] + d0 + 4);
#pragma unroll
        for (int e = 0; e < 8; ++e) { const float gg = e < 4 ? g0[e & 3] : g1[e & 3], bb = e < 4 ? b0[e & 3] : b1[e & 3];
            *(LAS unsigned*)(VT + (oct * 8 + e) * PITCH + pair * 4) = pk_bf16((va[e] - mua) * rsa * gg + bb, (vb[e] - mub) * rsb * gg + bb); } }
    __syncthreads();
    { const int ti = C.wave >> 1, td0 = (C.wave & 1) * 2, hh = C.lane >> 5; bf16_t* U = (bf16_t*)(C.out + 4194304);
#pragma unroll
        for (int q = 0; q < 2; ++q) { f32x16 acc = {0}; acc = mma_k128(WS_ + ti * 32 * PITCH, VT + (td0 + q) * 32 * PITCH, C.lane, acc);
            const int d = g * 128 + (td0 + q) * 32 + (C.lane & 31);
#pragma unroll
            for (int e = 0; e < 16; ++e) { const int i = ti * 32 + rowmap(e, hh); const float s = acc[e] + C.in[20][g * 128 + i]; bf16_t* up = U + (size_t)(tok0 + i) * 1024 + d; *up = to_bf1(bf1(*up) * s); } } }
    __syncthreads();
}

__device__ __forceinline__ void scan_item(Ctx& C, int item) {
    int seq, nc, c0; int r = item;
    if (r < 256) { seq = 16 + (r >> 7); r &= 127; nc = 32; c0 = 32 + (seq - 16) * 32; } else { r -= 256; seq = r >> 7; r &= 127; nc = 2; c0 = seq * 2; }
    const int h = r >> 3, dir = (r >> 2) & 1, quarter = r & 3; const int e0 = quarter * 2048 + C.tid * 4;
    float hv[4];
    if (seq >= 16) { const f32x4 v = *(const f32x4*)((dir ? C.in[3] : C.in[2]) + ((size_t)(seq - 16) * 16 + h) * 8192 + e0); hv[0] = v[0]; hv[1] = v[1]; hv[2] = v[2]; hv[3] = v[3]; } else { hv[0] = hv[1] = hv[2] = hv[3] = 0.f; }
    bf16_t* ST = WSP(bf16_t, OFF_ST); const float* AL = WSP(float, OFF_AL);
    for (int k = 0; k < nc; ++k) { const int c = c0 + (dir ? nc - 1 - k : k);
        u32x2* p = (u32x2*)(ST + ((size_t)(c * 16 + h) * 2 + dir) * 8192 + e0); const u32x2 sv = *p; const float dec = __expf(AL[(size_t)(c * 16 + h) * 2 + dir]);
        *p = (u32x2){pk_bf16(hv[0], hv[1]), pk_bf16(hv[2], hv[3])};
        hv[0] = dec * hv[0] + bf_lo(sv.x); hv[1] = dec * hv[1] + bf_hi(sv.x); hv[2] = dec * hv[2] + bf_lo(sv.y); hv[3] = dec * hv[3] + bf_hi(sv.y); }
    if (seq < 16) *(f32x4*)(C.out + 12582912 + (size_t)dir * 2097152 + ((size_t)seq * 16 + h) * 8192 + e0) = (f32x4){hv[0], hv[1], hv[2], hv[3]};
}

__device__ __forceinline__ void ssd_out_item(Ctx& C, int item) {
    const int chunk = item >> 4, h = item & 15, g = h >> 3, tok0 = chunk * 128; int t0, t1; seq_bounds(chunk, t0, t1);
    LAS uchar* CN = C.lds; LAS uchar* BN = C.lds + 34816; LAS uchar* XT = C.lds + 69632; LAS uchar* HF = C.lds + 87040; LAS uchar* HB = C.lds + 104448;
    LAS float* AF = (LAS float*)(C.lds + 121856); LAS float* AB = AF + 128; LAS float* DF = AF + 256; LAS float* DB = AF + 384; LAS float* SSP = AF + 512;
    const bf16_t* XBC = WSP(bf16_t, OFF_XBC); const float* cw = C.in[9]; const float* cb = C.in[10];
    if (C.wave == 0) { float totF, totB; chunk_scalars(WSP(float, OFF_DT), C.in[13], C.in[14], tok0, h, C.lane, AF, AB, DF, DB, totF, totB); }
#pragma unroll
    for (int k = 0; k < 4; ++k) { const int u = C.tid + 512 * k, oct = u & 15, j = u >> 4; float y[8];
        conv_silu8(XBC, cw, cb, tok0 + j, t0, t1, 1280 + g * 128 + oct * 8, y);
        *(LAS u32x4*)(CN + j * PITCH + oct * 16) = (u32x4){pk_bf16(y[0], y[1]), pk_bf16(y[2], y[3]), pk_bf16(y[4], y[5]), pk_bf16(y[6], y[7])};
        conv_silu8(XBC, cw, cb, tok0 + j, t0, t1, 1024 + g * 128 + oct * 8, y);
        *(LAS u32x4*)(BN + j * PITCH + oct * 16) = (u32x4){pk_bf16(y[0], y[1]), pk_bf16(y[2], y[3]), pk_bf16(y[4], y[5]), pk_bf16(y[6], y[7])}; }
    { const int pair = C.tid & 63, oct = C.tid >> 6, ch = h * 64 + oct * 8; float y0[8], y1[8];
        conv_silu8(XBC, cw, cb, tok0 + 2 * pair, t0, t1, ch, y0); conv_silu8(XBC, cw, cb, tok0 + 2 * pair + 1, t0, t1, ch, y1);
#pragma unroll
        for (int e = 0; e < 8; ++e) *(LAS unsigned*)(XT + (oct * 8 + e) * PITCH + pair * 4) = pk_bf16(y0[e], y1[e]); }
    { const u32x4* hs = (const u32x4*)(WSP(bf16_t, OFF_ST) + (size_t)(chunk * 16 + h) * 2 * 8192);
#pragma unroll
        for (int k = 0; k < 2; ++k) { const int v = C.tid + 512 * k, p = v >> 4, c8 = v & 15; *(LAS u32x4*)(HF + p * PITCH + c8 * 16) = hs[v]; *(LAS u32x4*)(HB + p * PITCH + c8 * 16) = hs[1024 + v]; } }
    __syncthreads();
    const int hh = C.lane >> 5, l31 = C.lane & 31;
    {
        const int ti = C.wave >> 1, tj0 = (C.wave & 1) * 2; f32x16 cbv[2];
#pragma unroll
        for (int q = 0; q < 2; ++q) { cbv[q] = (f32x16){0}; cbv[q] = mma_k128(CN + ti * 32 * PITCH, BN + (tj0 + q) * 32 * PITCH, C.lane, cbv[q]); }
        const float dsk = C.in[15][h];
#pragma unroll
        for (int q = 0; q < 2; ++q) { const int j = (tj0 + q) * 32 + l31; const float afj = AF[j], abj = AB[j], dfj = DF[j], dbj = DB[j];
#pragma unroll
            for (int e = 0; e < 16; ++e) { const int i = ti * 32 + rowmap(e, hh); float w = 0.f;
                if (j <= i) w += __expf(AF[i] - afj) * dfj;
                if (j >= i) w += __expf(AB[i] - abj) * dbj;
                cbv[q][e] = cbv[q][e] * w + (i == j ? dsk : 0.f); } }
        __syncthreads();
#pragma unroll
        for (int q = 0; q < 2; ++q) { const int j = (tj0 + q) * 32 + l31;
#pragma unroll
            for (int e = 0; e < 16; ++e) { const int i = ti * 32 + rowmap(e, hh); *(LAS bf16_t*)(BN + i * PITCH + j * 2) = to_bf1(cbv[q][e]); } }
    }
    __syncthreads();
    {
        const int ti = C.wave >> 1, tp = C.wave & 1; f32x16 ad = {0}, af = {0}, ab = {0};
        ad = mma_k128(BN + ti * 32 * PITCH, XT + tp * 32 * PITCH, C.lane, ad);
        af = mma_k128(CN + ti * 32 * PITCH, HF + tp * 32 * PITCH, C.lane, af);
        ab = mma_k128(CN + ti * 32 * PITCH, HB + tp * 32 * PITCH, C.lane, ab);
        const int p = h * 64 + tp * 32 + l31; const float nw = C.in[16][p]; bf16_t* ZS = WSP(bf16_t, OFF_ZS);
#pragma unroll
        for (int e = 0; e < 16; ++e) { const int i = ti * 32 + rowmap(e, hh); const float y = ad[e] + __expf(AF[i]) * af[e] + __expf(AB[i]) * ab[e];
            bf16_t* zp = ZS + (size_t)(tok0 + i) * 1024 + p; const float gz = y * bf1(*zp); *zp = to_bf1(gz * nw);
            float ss = gz * gz;
#pragma unroll
            for (int o = 1; o < 32; o <<= 1) ss += __shfl_xor(ss, o);
            if (l31 == 0) SSP[i * 2 + tp] = ss; }
    }
    __syncthreads();
    if (C.tid < 128) WSP(float, OFF_SSQ)[(size_t)(tok0 + C.tid) * 16 + h] = SSP[C.tid * 2] + SSP[C.tid * 2 + 1];
    __syncthreads();
}

__device__ __forceinline__ void ln1_pass(Ctx& C) {
    float* R1 = WSP(float, OFF_XBC); bf16_t* H2 = WSP(bf16_t, OFF_ZS); const float* MOD = WSP(float, OFF_MOD);
    const int gw = C.bid * 8 + C.wave, NGW = C.G * 8;
    for (int t = gw; t < MT; t += NGW) { const int mi = mod_idx(t); float* rp = R1 + (size_t)t * 1024; f32x4 v[4]; float s = 0.f;
#pragma unroll
        for (int j = 0; j < 4; ++j) { v[j] = *(const f32x4*)(rp + 4 * C.lane + 256 * j); s += (v[j][0] + v[j][1]) + (v[j][2] + v[j][3]); }
        const float mean = wave_sum(s) * (1.0f / 1024.0f); float q = 0.f;
#pragma unroll
        for (int j = 0; j < 4; ++j) { v[j] = v[j] - mean; q += (v[j][0] * v[j][0] + v[j][1] * v[j][1]) + (v[j][2] * v[j][2] + v[j][3] * v[j][3]); }
        const float rstd = rsqrtf(wave_sum(q) * (1.0f / 1024.0f) + EPS);
#pragma unroll
        for (int j = 0; j < 4; ++j) { const int c = 4 * C.lane + 256 * j; const f32x4 x1 = v[j] * rstd * *(const f32x4*)(C.in[24] + c) + *(const f32x4*)(C.in[25] + c);
            *(f32x4*)(rp + c) = x1;
            const f32x4 hv = x1 * (*(const f32x4*)(MOD + mi * 6144 + 4096 + c) + 1.0f) + *(const f32x4*)(MOD + mi * 6144 + 3072 + c);
            *(u32x2*)(H2 + (size_t)t * 1024 + c) = (u32x2){pk_bf16(hv[0], hv[1]), pk_bf16(hv[2], hv[3])}; }
    }
}
__device__ __forceinline__ void ln2_pass(Ctx& C) {
    const int gw = C.bid * 8 + C.wave, NGW = C.G * 8;
    for (int t = gw; t < MT; t += NGW) { float* rp = C.out + (size_t)t * 1024; f32x4 v[4]; float s = 0.f;
#pragma unroll
        for (int j = 0; j < 4; ++j) { v[j] = *(const f32x4*)(rp + 4 * C.lane + 256 * j); s += (v[j][0] + v[j][1]) + (v[j][2] + v[j][3]); }
        const float mean = wave_sum(s) * (1.0f / 1024.0f); float q = 0.f;
#pragma unroll
        for (int j = 0; j < 4; ++j) { v[j] = v[j] - mean; q += (v[j][0] * v[j][0] + v[j][1] * v[j][1]) + (v[j][2] * v[j][2] + v[j][3] * v[j][3]); }
        const float rstd = rsqrtf(wave_sum(q) * (1.0f / 1024.0f) + EPS);
#pragma unroll
        for (int j = 0; j < 4; ++j) { const int c = 4 * C.lane + 256 * j; *(f32x4*)(rp + c) = v[j] * rstd * *(const f32x4*)(C.in[28] + c) + *(const f32x4*)(C.in[29] + c); }
    }
}

#define XB_TMO      128
#define XB_XCNT(j)  (256  + 64 * (j))
#define XB_XSUB(j)  (1280 + 64 * (j))
#define XB_XGEN(j)  (2304 + 64 * (j))
#define XB_TOP      3328
#define XB_TOPGEN   3392
#define XCD_BAR_WORDS 3456
#define XB_SPIN_CAP (1u << 18)

__device__ __forceinline__ unsigned xb_ld(unsigned* p)              { return __hip_atomic_load(p, __ATOMIC_RELAXED, __HIP_MEMORY_SCOPE_AGENT); }
__device__ __forceinline__ unsigned xb_add(unsigned* p, unsigned v) { return __hip_atomic_fetch_add(p, v, __ATOMIC_RELAXED, __HIP_MEMORY_SCOPE_AGENT); }
__device__ __forceinline__ unsigned xb_xcc_id() { return (unsigned)__builtin_amdgcn_s_getreg((3 << 11) | 20) & 0xFu; }
#define XB_SPIN(cond, bar) do { unsigned _sp = 0; while (cond) { __builtin_amdgcn_s_sleep(1); \
    if ((++_sp & 255u) == 0u) { if (xb_ld(&(bar)[XB_TMO])) break; if (_sp > XB_SPIN_CAP) { atomicAdd(&(bar)[XB_TMO], 1u); break; } } } } while (0)

struct XcdBarrier {
    unsigned* bar; unsigned x;
    volatile LAS unsigned* st;
};

__device__ __forceinline__ XcdBarrier xcd_barrier_post(unsigned* bar, volatile LAS unsigned* st) {
    XcdBarrier b; b.bar = bar; b.x = xb_xcc_id(); b.st = st;
    if (threadIdx.x == 0) (void)xb_add(&bar[XB_XCNT(b.x)], 1u);
    return b;
}
__device__ __forceinline__ void xcd_barrier_complete(unsigned* bar, unsigned x, unsigned& nloc, unsigned& nx) {
    const unsigned G = gridDim.x * gridDim.y * gridDim.z;
    unsigned sum, cnt, mine, sp = 0u;
    for (;;) {
        sum = 0u; cnt = 0u; mine = 0u;
#pragma unroll
        for (unsigned j = 0; j < 16; ++j) { const unsigned c = xb_ld(&bar[XB_XCNT(j)]); sum += c; cnt += (c > 0u) ? 1u : 0u; mine = (j == x) ? c : mine; }
        if (sum == G) break;
        __builtin_amdgcn_s_sleep(1);
        if ((++sp & 255u) == 0u) { if (xb_ld(&bar[XB_TMO])) break; if (sp > XB_SPIN_CAP) { atomicAdd(&bar[XB_TMO], 1u); break; } }
    }
    nloc = mine > 0u ? mine : 1u; nx = cnt > 0u ? cnt : 1u;
}

__device__ __forceinline__ void xcd_barrier(const XcdBarrier& b) {
    asm volatile("s_waitcnt vmcnt(0)" ::: "memory");
    __syncthreads();
    if (threadIdx.x == 0) {
        unsigned* bar = b.bar;
        __builtin_amdgcn_s_waitcnt(0);
        unsigned nloc = b.st[0], nx = b.st[1];
        if (nloc == 0u) { xcd_barrier_complete(bar, b.x, nloc, nx); b.st[0] = nloc; b.st[1] = nx; }
        const unsigned old = xb_add(&bar[XB_XSUB(b.x)], 1u);
        const unsigned gen = old / nloc;
        if (old + 1u == (gen + 1u) * nloc) {
            __builtin_amdgcn_fence(__ATOMIC_RELEASE, "agent");
            asm volatile("s_waitcnt vmcnt(0)" ::: "memory");
            const unsigned og = xb_add(&bar[XB_TOP], 1u);
            const unsigned tg = og / nx;
            if (og + 1u == (tg + 1u) * nx) xb_add(&bar[XB_TOPGEN], 1u);
            else XB_SPIN(xb_ld(&bar[XB_TOPGEN]) == tg, bar);
            __builtin_amdgcn_fence(__ATOMIC_ACQUIRE, "agent");
            xb_add(&bar[XB_XGEN(b.x)], 1u);
            asm volatile("s_waitcnt vmcnt(0)" ::: "memory");
        } else {
            XB_SPIN(xb_ld(&bar[XB_XGEN(b.x)]) == gen, bar);
            __builtin_amdgcn_fence(__ATOMIC_ACQUIRE, "agent");
            asm volatile("s_waitcnt vmcnt(0)" ::: "memory");
        }
    }
    __syncthreads();
}

constexpr int NPHASE = 12;
__global__ void __launch_bounds__(NTHREADS, 2) fwd_kernel(Args a) {
    extern __shared__ __attribute__((aligned(16))) unsigned char smem[];
    cg::grid_group grid = cg::this_grid();
    Ctx C;
#pragma unroll
    for (int i = 0; i < 30; ++i) C.in[i] = a.in[i];
    C.out = a.out; C.ws = a.ws; C.lds = (LAS uchar*)smem; C.tid = threadIdx.x; C.lane = C.tid & 63; C.wave = __builtin_amdgcn_readfirstlane(C.tid >> 6); C.G = gridDim.x; C.bid = blockIdx.x;
    const int lo = a.ph_lo, hi = a.ph_hi;
    volatile LAS unsigned* bst = (volatile LAS unsigned*)(C.lds + 131072);
    if (C.tid < 16) bst[C.tid] = 0u;
    __syncthreads();
    XcdBarrier bar; bar.bar = (unsigned*)(C.ws + OFF_CTL); bar.x = 0; bar.st = bst;
    if (hi - lo > 1) bar = xcd_barrier_post((unsigned*)(C.ws + OFF_CTL), bst);
    if (hi > NPHASE) grid.sync();
#define IN(k) (lo <= (k) && (k) < hi)
#define SEAM(k) do { if (IN(k) && IN((k) + 1)) xcd_barrier(bar); } while (0)
    if (IN(0)) { phase0(C); if (DUP == 1) { __syncthreads(); phase0(C); } }
    if (DUP == 100) { for (int q_ = 0; q_ < 10; ++q_) xcd_barrier(bar); }
    SEAM(0);
    if (IN(1)) { phase1(C); if (DUP == 2) { __syncthreads(); phase1(C); } }
    SEAM(1);
    if (IN(2)) {
        pg8::Gemm g{WSP(bf16_t, OFF_H1), WSP(bf16_t, OFF_WIN), MT, NIN, 1024}; pg8::StaticOrder S; S.init(MT, NIN, C.G, C.bid);
        EpiIn E{WSP(bf16_t, OFF_ZS), WSP(bf16_t, OFF_XBC), (bf16_t*)(C.out + 4194304), WSP(bf16_t, OFF_V), WSP(bf16_t, OFF_G), WSP(float, OFF_DT), WSP(float, OFF_VSTAT), C.in[11], C.in[12]};
        pg8::gemm_phase<EpiIn, pg8::StaticOrder, false>(C.lds, g, S, E, nullptr);
        if (DUP == 3) { __syncthreads(); pg8::gemm_phase<EpiIn, pg8::StaticOrder, false>(C.lds, g, S, E, nullptr); }
    }
    SEAM(2);
    if (IN(3)) { for (int it = C.bid; it < 1536 + 768; it += C.G) { if (it < 1536) ssd_states_item(C, it); else sgu_item(C, it - 1536); } }
    if (DUP == 4 && IN(3)) { for (int it = C.bid; it < 1536; it += C.G) ssd_states_item(C, it); }
    SEAM(3);
    if (IN(4)) { for (int it = C.bid; it < 2304; it += C.G) scan_item(C, it); }
    SEAM(4);
    if (IN(5)) { for (int it = C.bid; it < 1536; it += C.G) ssd_out_item(C, it); }
    SEAM(5);
    if (IN(6)) {
        { pg8::Gemm g{WSP(bf16_t, OFF_ZS), WSP(bf16_t, OFF_WPA), MT, 1024, 1024}; pg8::StaticOrder S; S.init(MT, 1024, C.G, C.bid);
          EpiPA E{WSP(float, OFF_ST), WSP(bf16_t, OFF_G), WSP(float, OFF_SSQ)};
          pg8::gemm_phase<EpiPA, pg8::StaticOrder, false>(C.lds, g, S, E, nullptr);
          if (DUP == 7) { __syncthreads(); pg8::gemm_phase<EpiPA, pg8::StaticOrder, false>(C.lds, g, S, E, nullptr); } }
        __syncthreads();
        { pg8::Gemm g{(const bf16_t*)(C.out + 4194304), WSP(bf16_t, OFF_WPB), MT, 1024, 1024}; pg8::StaticOrder S; S.init(MT, 1024, C.G, C.bid);
          EpiPB E{WSP(float, OFF_ST), WSP(bf16_t, OFF_G), WSP(bf16_t, OFF_H1)};
          pg8::gemm_phase<EpiPB, pg8::StaticOrder, false>(C.lds, g, S, E, nullptr); }
    }
    SEAM(6);
    if (IN(7)) {
        pg8::Gemm g{WSP(bf16_t, OFF_H1), WSP(bf16_t, OFF_WOUT), MT, 1024, 1024}; pg8::StaticOrder S; S.init(MT, 1024, C.G, C.bid);
        EpiRes E{WSP(float, OFF_XBC), C.in[0], C.in[1], WSP(float, OFF_POS), WSP(float, OFF_MOD) + 2048, 1};
        pg8::gemm_phase<EpiRes, pg8::StaticOrder, false>(C.lds, g, S, E, nullptr);
    }
    SEAM(7);
    if (IN(8)) ln1_pass(C);
    SEAM(8);
    if (IN(9)) {
        pg8::Gemm g{WSP(bf16_t, OFF_ZS), WSP(bf16_t, OFF_WFF1), MT, DFF, 1024}; pg8::StaticOrder S; S.init(MT, DFF, C.G, C.bid);
        EpiFF1 E{WSP(bf16_t, OFF_G)};
        pg8::gemm_phase<EpiFF1, pg8::StaticOrder, false>(C.lds, g, S, E, nullptr);
        if (DUP == 10) { __syncthreads(); pg8::gemm_phase<EpiFF1, pg8::StaticOrder, false>(C.lds, g, S, E, nullptr); }
    }
    SEAM(9);
    if (IN(10)) {
        pg8::Gemm g{WSP(bf16_t, OFF_G), WSP(bf16_t, OFF_WFF2), MT, 1024, DFF}; pg8::StaticOrder S; S.init(MT, 1024, C.G, C.bid);
        EpiRes E{C.out, WSP(float, OFF_XBC), nullptr, nullptr, WSP(float, OFF_MOD) + 5120, 0};
        pg8::gemm_phase<EpiRes, pg8::StaticOrder, false>(C.lds, g, S, E, nullptr);
        if (DUP == 11) { __syncthreads(); pg8::gemm_phase<EpiRes, pg8::StaticOrder, false>(C.lds, g, S, E, nullptr); }
    }
    SEAM(10);
    if (IN(11)) ln2_pass(C);
#undef IN
#undef SEAM
}

extern "C" void kernel_launch(void* const* d_in, const int* in_sizes, int n_in, void* d_out, int out_size, void* d_ws, size_t ws_size, hipStream_t stream) {
    static int grid = 0;
    if (grid == 0) {
        if (n_in != 30 || out_size != 16777216 || ws_size < WS_END) { fprintf(stderr, "kernel_launch: unexpected shapes (n_in %d out %d ws %zu)\n", n_in, out_size, ws_size); grid = -1; return; }
        int dev = 0, cus = 0, per_cu = 0;
        (void)hipGetDevice(&dev); (void)hipDeviceGetAttribute(&cus, hipDeviceAttributeMultiprocessorCount, dev);
        if (hipFuncSetAttribute((const void*)fwd_kernel, hipFuncAttributeMaxDynamicSharedMemorySize, LDS_BYTES) != hipSuccess) { fprintf(stderr, "hipFuncSetAttribute failed\n"); grid = -1; return; }
        if (hipOccupancyMaxActiveBlocksPerMultiprocessor(&per_cu, (const void*)fwd_kernel, NTHREADS, LDS_BYTES) != hipSuccess || per_cu < 1) per_cu = 1;
        (void)hipGetLastError();
        grid = cus > 0 ? cus : 256;
    }
    if (grid < 0) return;
    Args a{};
    for (int i = 0; i < 30; ++i) a.in[i] = (const float*)d_in[i];
    a.out = (float*)d_out; a.ws = (unsigned char*)d_ws;
    if (hipMemsetAsync((char*)d_ws + OFF_CTL, 0, 16384, stream) != hipSuccess) { fprintf(stderr, "memset failed\n"); return; }
#if MULTI_LAUNCH
    for (int ph = 0; ph < NPHASE; ++ph) { a.ph_lo = ph; a.ph_hi = ph + 1; hipLaunchKernelGGL(fwd_kernel, dim3(grid), dim3(NTHREADS), LDS_BYTES, stream, a); }
#else
    a.ph_lo = 0; a.ph_hi = NPHASE;
    void* args[] = {&a};
    hipError_t e = hipLaunchCooperativeKernel((const void*)fwd_kernel, dim3(grid), dim3(NTHREADS), args, LDS_BYTES, stream);
    if (e != hipSuccess) fprintf(stderr, "cooperative launch failed: %s (grid %d)\n", hipGetErrorString(e), grid);
#endif
}
```

```cpp
#include <hip/hip_runtime.h>
#include <hip/hip_cooperative_groups.h>
#include <cstdio>
namespace cg = cooperative_groups;
#ifndef DUP
#define DUP 0
#endif
#ifndef MULTI_LAUNCH
#define MULTI_LAUNCH 0
#endif
namespace pg8 {
#define PG8_LAS __attribute__((address_space(3)))
typedef unsigned short bf16_t;
typedef short bf16x8 __attribute__((ext_vector_type(8)));
typedef float f32x4 __attribute__((ext_vector_type(4)));
typedef unsigned u32x4 __attribute__((ext_vector_type(4)));
constexpr int BM = 256, BK = 64, HALF = 128, HTB = HALF * BK * 2  , STAGE_BYTES = 8 * HTB, NXCD = 8, WGM = 8;

__host__ __device__ __forceinline__ int lds_byte(int r, int c) { const int st = (r >> 4) * 2 + (c >> 5), rr = r & 15, cc = c & 31, ob = rr * 64 + cc * 2; return st * 1024 + (ob ^ (((ob >> 9) & 1) << 5)); }
__host__ __device__ __forceinline__ void stage_rc(int b, int& R, int& C) { const int st = b / 1024, sb = b % 1024, swz = sb ^ (((sb >> 9) & 1) << 5); R = (st >> 1) * 16 + swz / 64; C = (st & 1) * 32 + (swz % 64) / 2; }
__host__ __device__ __forceinline__ int perm32(int rho) { const int n = rho >> 4, i = rho & 15; return 8 * (i >> 2) + 4 * n + (i & 3); }

struct Unit { int pm, pn; };
struct Gemm { const bf16_t* A; const bf16_t* Bt; int M, N, K; };

struct StaticOrder {
    int nM, nN, nwg, G, c;
    __host__ __device__ void init(int M, int N, int G_, int c_) { nM = M / BM; nN = N / BM; nwg = nM * nN; G = G_; c = c_; }
    __host__ __device__ bool next(int i, Unit& u) const {
        const long L = (long)i * G + c; if (L >= nwg) return false;
        int wgid = (int)L; { const int q = nwg / NXCD, r = nwg % NXCD, xcd = wgid % NXCD, off = wgid / NXCD; wgid = (xcd < r ? xcd * (q + 1) : r * (q + 1) + (xcd - r) * q) + off; }
        const int nig = WGM * nN, gid = wgid / nig, fm = gid * WGM, gsz = (nM - fm) < WGM ? (nM - fm) : WGM;
        u.pm = fm + ((wgid % nig) % gsz); u.pn = (wgid % nig) / gsz; return true;
    }
    __device__ __forceinline__ void a_ready(const Unit&) const {}
    __device__ __forceinline__ void done(const Unit&) const {}
};
typedef float f32x2 __attribute__((ext_vector_type(2)));
__device__ __forceinline__ f32x2 gelu_pk(f32x2 v) {
    const f32x2 av = __builtin_elementwise_abs(v), d = av * 0.2316418882f + 1.0f;
    f32x2 t; t.x = __builtin_amdgcn_rcpf(d.x); t.y = __builtin_amdgcn_rcpf(d.y);
    f32x2 q = t * 0.5307027145f + (-0.7265760135f); q = q * t + 0.7107068705f; q = q * t + (-0.142248368f); q = q * t + 0.127414796f; q = q * t;
    const f32x2 s = (v * v) * (-0.72134752044f);
    f32x2 e; e.x = __builtin_amdgcn_exp2f(s.x); e.y = __builtin_amdgcn_exp2f(s.y);
    const f32x2 m = v * (q * e), r = v - m;
    f32x2 o; o.x = v.x < 0.f ? m.x : r.x; o.y = v.y < 0.f ? m.y : r.y; return o;
}
template <class Epi, class Sched, bool STAMP = false>
__device__ __forceinline__ void gemm_phase(PG8_LAS unsigned char* lds, const Gemm g, const Sched& S, const Epi& E, unsigned long long* stamps) {
    const int tid = threadIdx.x, wid = __builtin_amdgcn_readfirstlane(tid >> 6), lane = tid & 63, wr = wid >> 2, wc = wid & 3, fr = lane & 15, fq = lane >> 4;
    const int K = g.K, nt = K / BK;
    int ts_lo = 0, ts_hi = 0, nts = 0; const unsigned long long rt_entry = STAMP ? (unsigned long long)wall_clock64() : 0ull;
#define PG8_STAMP() do { if (STAMP && wid == 0 && nts < 64) { const unsigned long long _c = (unsigned long long)clock64(); \
        ts_lo = (lane == nts) ? (int)(unsigned)_c : ts_lo; ts_hi = (lane == nts) ? (int)(unsigned)(_c >> 32) : ts_hi; ++nts; } } while (0)
    PG8_STAMP();
    unsigned voffA[2], voffB[2];
#pragma unroll
    for (int i = 0; i < 2; ++i) { int R, C; stage_rc(tid * 16 + i * 8192, R, C); const int Rb = Epi::PERM ? ((R & ~31) + perm32(R & 31)) : R;
        voffA[i] = (unsigned)(R * K + C) * 2u; voffB[i] = (unsigned)(Rb * K + C) * 2u; }
    const size_t kstep = (size_t)(BK * 2);
    const size_t hstep = (size_t)HALF * K * 2;
    const size_t tstep = 2 * hstep;
    const unsigned ldsw = (unsigned)wid * 1024u;
    const int aoff = lds_byte(wr * 64 + fr, fq * 8), boff = lds_byte(wc * 32 + fr, fq * 8);
#define PG8_SA(b, h) (((b) * 2 + (h)) * HTB)
#define PG8_SB(b, h) ((4 + (b) * 2 + (h)) * HTB)
#define PG8_STAGE(bufoff, gbase, voff) do { _Pragma("unroll") for (int _i = 0; _i < 2; ++_i) \
        __builtin_amdgcn_global_load_lds((const unsigned*)((const char*)(gbase) + (voff)[_i]), (PG8_LAS unsigned*)(lds + (bufoff) + ldsw + _i * 8192), 16, 0, 0); } while (0)
#define PG8_LDA(dst, b, h) do { _Pragma("unroll") for (int m = 0; m < 4; ++m) _Pragma("unroll") for (int k = 0; k < 2; ++k) dst[m][k] = *(const PG8_LAS bf16x8*)(lds + PG8_SA(b, h) + aoff + m * 2048 + k * 1024); } while (0)
#define PG8_LDB(dst, b, h) do { _Pragma("unroll") for (int n = 0; n < 2; ++n) _Pragma("unroll") for (int k = 0; k < 2; ++k) dst[n][k] = *(const PG8_LAS bf16x8*)(lds + PG8_SB(b, h) + boff + n * 2048 + k * 1024); } while (0)
#define PG8_MMA(ai, bj, At, Bt) do { __builtin_amdgcn_s_setprio(1); _Pragma("unroll") for (int m = 0; m < 4; ++m) _Pragma("unroll") for (int n = 0; n < 2; ++n) _Pragma("unroll") for (int k = 0; k < 2; ++k) \
        acc[ai][bj][m][n] = __builtin_amdgcn_mfma_f32_16x16x32_bf16(Bt[n][k], At[m][k], acc[ai][bj][m][n], 0, 0, 0); __builtin_amdgcn_s_setprio(0); } while (0)
#define PG8_WAIT_V(n) asm volatile("s_waitcnt vmcnt(" #n ")" ::: "memory")
#define PG8_WAIT_L(n) asm volatile("s_waitcnt lgkmcnt(" #n ")" ::: "memory")
#define PG8_BAR __builtin_amdgcn_s_barrier()
#define PG8_SCHED __builtin_amdgcn_sched_barrier(0)
    Unit cur, nxt; int ui = 0;
    if (!S.next(0, cur)) return;
    f32x4 acc[2][2][4][2];
#pragma unroll
    for (int a = 0; a < 2; ++a)
#pragma unroll
        for (int b = 0; b < 2; ++b)
#pragma unroll
            for (int m = 0; m < 4; ++m)
#pragma unroll
                for (int n = 0; n < 2; ++n) acc[a][b][m][n] = (f32x4){0.f, 0.f, 0.f, 0.f};
    bf16x8 At[4][2], B0[2][2], B1[2][2];
    const char* cA = (const char*)g.A + (size_t)cur.pm * tstep; const char* cB = (const char*)g.Bt + (size_t)cur.pn * tstep;
    S.a_ready(cur);
    PG8_STAGE(PG8_SB(0, 0), cB, voffB); PG8_STAGE(PG8_SA(0, 0), cA, voffA); PG8_STAGE(PG8_SB(0, 1), cB + hstep, voffB); PG8_STAGE(PG8_SA(0, 1), cA + hstep, voffA);
    if (wr == 1) PG8_BAR;
    PG8_WAIT_V(4); PG8_BAR;
    PG8_STAGE(PG8_SB(1, 0), cB + kstep, voffB); PG8_STAGE(PG8_SA(1, 0), cA + kstep, voffA); PG8_STAGE(PG8_SB(1, 1), cB + hstep + kstep, voffB);
    PG8_WAIT_V(6); PG8_BAR;
    PG8_STAMP();
    for (;;) {
        const bool has_next = S.next(ui + 1, nxt);
        const char* nA = has_next ? (const char*)g.A + (size_t)nxt.pm * tstep : cA; const char* nB = has_next ? (const char*)g.Bt + (size_t)nxt.pn * tstep : cB;
        for (int t = 0; t < nt; t += 2) {
            const bool last = (t == nt - 2);
            const char* a1 = cA + (size_t)(t + 1) * kstep;
            const char* a2 = last ? nA : cA + (size_t)(t + 2) * kstep; const char* b2 = last ? nB : cB + (size_t)(t + 2) * kstep;
            const char* a3 = a2 + kstep; const char* b3 = b2 + kstep;
            if (last && has_next) S.a_ready(nxt);
            PG8_LDB(B0, 0, 0); PG8_SCHED; PG8_LDA(At, 0, 0); PG8_STAGE(PG8_SA(1, 1), a1 + hstep, voffA);
            PG8_WAIT_L(8); PG8_BAR; PG8_WAIT_L(0); PG8_MMA(0, 0, At, B0); PG8_BAR; PG8_SCHED;
            PG8_LDB(B1, 0, 1); PG8_STAGE(PG8_SB(0, 0), b2, voffB);
            PG8_BAR; PG8_WAIT_L(0); PG8_MMA(0, 1, At, B1); PG8_BAR;
            PG8_LDA(At, 0, 1); PG8_STAGE(PG8_SA(0, 0), a2, voffA);
            PG8_BAR; PG8_WAIT_L(0); PG8_MMA(1, 0, At, B0); PG8_BAR; PG8_SCHED;
            PG8_STAGE(PG8_SB(0, 1), b2 + hstep, voffB);
            PG8_WAIT_V(6); PG8_BAR; PG8_MMA(1, 1, At, B1); PG8_BAR;
            PG8_LDB(B0, 1, 0); PG8_SCHED; PG8_LDA(At, 1, 0); PG8_STAGE(PG8_SA(0, 1), a2 + hstep, voffA);
            PG8_WAIT_L(8); PG8_BAR; PG8_WAIT_L(0); PG8_MMA(0, 0, At, B0); PG8_BAR; PG8_SCHED;
            PG8_LDB(B1, 1, 1); PG8_STAGE(PG8_SB(1, 0), b3, voffB);
            PG8_BAR; PG8_WAIT_L(0); PG8_MMA(0, 1, At, B1); PG8_BAR;
            PG8_LDA(At, 1, 1); PG8_STAGE(PG8_SA(1, 0), a3, voffA);
            PG8_BAR; PG8_WAIT_L(0); PG8_MMA(1, 0, At, B0); PG8_BAR; PG8_SCHED;
            PG8_STAGE(PG8_SB(1, 1), b3 + hstep, voffB);
            PG8_WAIT_V(6); PG8_BAR; PG8_MMA(1, 1, At, B1); PG8_BAR;
        }
        PG8_STAMP();
        if constexpr (!Epi::AFTER_DRAIN) { E(acc, cur, wr, wc, fr, fq); S.done(cur); }
        PG8_STAMP();
        if (!has_next) break;
#pragma unroll
        for (int a = 0; a < 2; ++a)
#pragma unroll
            for (int b = 0; b < 2; ++b)
#pragma unroll
                for (int m = 0; m < 4; ++m)
#pragma unroll
                    for (int n = 0; n < 2; ++n) acc[a][b][m][n] = (f32x4){0.f, 0.f, 0.f, 0.f};
        cur = nxt; cA = nA; cB = nB; ++ui;
    }
    PG8_WAIT_V(0);
    if (wr == 0) PG8_BAR;
    PG8_BAR;
    if constexpr (Epi::AFTER_DRAIN) { E.fused(acc, cur, wr, wc, fr, fq, lds, wid, lane); S.done(cur); }
    PG8_STAMP();
    if (STAMP && wid == 0) { stamps[lane] = lane < nts ? (((unsigned long long)(unsigned)ts_hi << 32) | (unsigned)ts_lo) : 0ull;
        if (lane == 62) stamps[62] = rt_entry; if (lane == 63) stamps[63] = (unsigned long long)wall_clock64(); }
#undef PG8_STAMP
#undef PG8_SA
#undef PG8_SB
#undef PG8_STAGE
#undef PG8_LDA
#undef PG8_LDB
#undef PG8_MMA
#undef PG8_WAIT_V
#undef PG8_WAIT_L
#undef PG8_BAR
#undef PG8_SCHED
}
}

#define LAS __attribute__((address_space(3)))
typedef unsigned short bf16_t;
typedef unsigned char uchar;
typedef short bf16x8 __attribute__((ext_vector_type(8)));
typedef float f32x4 __attribute__((ext_vector_type(4)));
typedef float f32x2 __attribute__((ext_vector_type(2)));
typedef float f32x16 __attribute__((ext_vector_type(16)));
typedef unsigned u32x4 __attribute__((ext_vector_type(4)));
typedef unsigned u32x2 __attribute__((ext_vector_type(2)));

constexpr int MT = 12288, DM = 1024, NCTX_TOK = 4096, NCHUNK = 96, NIN = 6656, NIN_ROWS = 6912, DFF = 4096;
constexpr float DN_ALPHA = 1.189207115002721f;
constexpr float EPS = 1e-5f;
constexpr int LDS_BYTES = 131072 + 64;
constexpr int NTHREADS = 512;

constexpr size_t OFF_WIN = 0;
constexpr size_t OFF_WPA = OFF_WIN + (size_t)NIN_ROWS * 1024 * 2;
constexpr size_t OFF_WPB = OFF_WPA + 2097152;
constexpr size_t OFF_WOUT = OFF_WPB + 2097152;
constexpr size_t OFF_WFF1 = OFF_WOUT + 2097152;
constexpr size_t OFF_WFF2 = OFF_WFF1 + 8388608;
constexpr size_t OFF_WSP = OFF_WFF2 + 8388608;
constexpr size_t OFF_MODP = OFF_WSP + 262144;
constexpr size_t OFF_MOD = OFF_MODP + 16 * 3 * 6144 * 4;
constexpr size_t OFF_POS = OFF_MOD + 3 * 6144 * 4;
constexpr size_t OFF_DT = OFF_POS + 64 * 512 * 4;
constexpr size_t OFF_VSTAT = OFF_DT + (size_t)MT * 32 * 4;
constexpr size_t OFF_SSQ = OFF_VSTAT + (size_t)MT * 16 * 2 * 4;
constexpr size_t OFF_AL = OFF_SSQ + (size_t)MT * 32 * 4;
constexpr size_t OFF_H1 = OFF_AL + 96 * 16 * 2 * 4;
constexpr size_t OFF_ZS = OFF_H1 + (size_t)MT * 1024 * 2;
constexpr size_t OFF_XBC = OFF_ZS + (size_t)MT * 1024 * 2;
constexpr size_t OFF_V = OFF_XBC + (size_t)MT * 1536 * 2;
constexpr size_t OFF_G = OFF_V + (size_t)MT * 1024 * 2;
constexpr size_t OFF_ST = OFF_G + (size_t)MT * 2048 * 2;
constexpr size_t OFF_CTL = OFF_ST + (size_t)MT * 1024 * 4;
constexpr size_t WS_END = OFF_CTL + 16384;
static_assert(WS_END <= 268435456ull, "workspace");
static_assert((size_t)MT * 1024 * 4 <= (size_t)MT * 1536 * 2 + (size_t)MT * 1024 * 2, "R1 fits in XBC+V");

struct Args {
    const float* in[30];
    float* out;
    unsigned char* ws;
    int ph_lo, ph_hi;
};

typedef __bf16 bf16x2_t __attribute__((ext_vector_type(2)));
__device__ __forceinline__ unsigned pk_bf16(float lo, float hi) { bf16x2_t v = {(__bf16)lo, (__bf16)hi}; return __builtin_bit_cast(unsigned, v); }
__device__ __forceinline__ float bf_lo(unsigned u) { return __uint_as_float(u << 16); }
__device__ __forceinline__ float bf_hi(unsigned u) { return __uint_as_float(u & 0xffff0000u); }
__device__ __forceinline__ float bf1(bf16_t b) { return __uint_as_float(((unsigned)b) << 16); }
__device__ __forceinline__ bf16_t to_bf1(float f) { return (bf16_t)(pk_bf16(f, 0.f) & 0xffffu); }
__device__ __forceinline__ float fast_rcp(float x) { return __builtin_amdgcn_rcpf(x); }
__device__ __forceinline__ float sigmoidf_(float v) { return fast_rcp(1.0f + __expf(-v)); }
__device__ __forceinline__ float siluf_(float v) { return v * sigmoidf_(v); }
__device__ __forceinline__ float softplusf_(float v) { return v > 20.f ? v : log1pf(__expf(v)); }
__device__ __forceinline__ float wave_sum(float v) {
#pragma unroll
    for (int o = 1; o < 64; o <<= 1) v += __shfl_xor(v, o);
    return v;
}
__device__ __forceinline__ void unpack8(u32x4 v, float (&o)[8]) {
    o[0] = bf_lo(v.x); o[1] = bf_hi(v.x); o[2] = bf_lo(v.y); o[3] = bf_hi(v.y); o[4] = bf_lo(v.z); o[5] = bf_hi(v.z); o[6] = bf_lo(v.w); o[7] = bf_hi(v.w);
}
__device__ __forceinline__ int mod_idx(int t) { return t < NCTX_TOK ? 0 : 1 + ((t - NCTX_TOK) >> 12); }
__device__ __forceinline__ void seq_bounds(int chunk, int& t0, int& t1) {
    if (chunk < 32) { t0 = (chunk >> 1) * 256; t1 = t0 + 256; } else { t0 = NCTX_TOK + ((chunk - 32) >> 5) * 4096; t1 = t0 + 4096; }
}

using pg8::Unit;
struct EpiIn {
    static constexpr bool PERM = true, AFTER_DRAIN = false;
    bf16_t *ZS, *XBC, *U, *V, *G; float* DT; float* VSTAT; const float *dtbf, *dtbb;
    __device__ __forceinline__ void operator()(const f32x4 (&acc)[2][2][4][2], const Unit& u, int wr, int wc, int fr, int fq) const {
        const int pn = u.pn; const int row0 = u.pm * 256 + wr * 64 + fr;
        bf16_t* dst; int ld, cb, act;
        if (pn < 4) { dst = ZS; ld = 1024; cb = pn * 256; act = 1; }
        else if (pn < 10) { dst = XBC; ld = 1536; cb = (pn - 4) * 256; act = 0; }
        else if (pn < 14) { dst = U; ld = 1024; cb = (pn - 10) * 256; act = 2; }
        else if (pn < 18) { dst = V; ld = 1024; cb = (pn - 14) * 256; act = 3; }
        else { dst = G; ld = 2048; cb = (pn - 18) * 256; act = 4; }
        const int col0 = cb + wc * 32 + 8 * fq;
#pragma unroll
        for (int ai = 0; ai < 2; ++ai)
#pragma unroll
            for (int m = 0; m < 4; ++m) {
                const int r = row0 + ai * 128 + m * 16; bf16_t* rowp = dst + (size_t)r * ld + col0;
                float s = 0.f, ss = 0.f;
#pragma unroll
                for (int bj = 0; bj < 2; ++bj) {
                    f32x4 v0 = acc[ai][bj][m][0], v1 = acc[ai][bj][m][1];
                    if (act == 1) {
#pragma unroll
                        for (int j = 0; j < 4; ++j) { v0[j] = siluf_(v0[j]); v1[j] = siluf_(v1[j]); }
                    } else if (act == 2 || act == 3) {
                        f32x2 a = pg8::gelu_pk((f32x2){v0[0], v0[1]}), b = pg8::gelu_pk((f32x2){v0[2], v0[3]}), c = pg8::gelu_pk((f32x2){v1[0], v1[1]}), d = pg8::gelu_pk((f32x2){v1[2], v1[3]});
                        v0 = (f32x4){a.x, a.y, b.x, b.y}; v1 = (f32x4){c.x, c.y, d.x, d.y};
                        if (act == 3) {
#pragma unroll
                            for (int j = 0; j < 4; ++j) { s += v0[j] + v1[j]; ss += v0[j] * v0[j] + v1[j] * v1[j]; }
                        }
                    } else if (act == 4) {
#pragma unroll
                        for (int j = 0; j < 4; ++j) { v0[j] = sigmoidf_(v0[j]); v1[j] = sigmoidf_(v1[j]); }
                    }
                    u32x4 w; w.x = pk_bf16(v0[0], v0[1]); w.y = pk_bf16(v0[2], v0[3]); w.z = pk_bf16(v1[0], v1[1]); w.w = pk_bf16(v1[2], v1[3]);
                    *(u32x4*)(rowp + bj * 128) = w;
                }
                if (act == 3) {
                    s += __shfl_xor(s, 16); s += __shfl_xor(s, 32); ss += __shfl_xor(ss, 16); ss += __shfl_xor(ss, 32);
                    if (fq == 0) *(f32x2*)(VSTAT + ((size_t)r * 16 + (pn - 14) * 4 + wc) * 2) = (f32x2){s, ss};
                }
            }
    }
};
struct EpiPA {
    static constexpr bool PERM = false, AFTER_DRAIN = false;
    float* PA; const bf16_t* G; const float* SSQ;
    __device__ __forceinline__ void operator()(const f32x4 (&acc)[2][2][4][2], const Unit& u, int wr, int wc, int fr, int fq) const {
        const int row0 = u.pm * 256 + wr * 64 + fr, col0 = u.pn * 256 + wc * 32 + 4 * fq;
#pragma unroll
        for (int ai = 0; ai < 2; ++ai)
#pragma unroll
            for (int m = 0; m < 4; ++m) {
                const int r = row0 + ai * 128 + m * 16;
                const f32x4* sq = (const f32x4*)(SSQ + (size_t)r * 32); float tot = 0.f;
#pragma unroll
                for (int k = 0; k < 8; ++k) { const f32x4 q = sq[k]; tot += (q[0] + q[1]) + (q[2] + q[3]); }
                const float rstd = rsqrtf(tot * (1.0f / 1024.0f) + EPS);
#pragma unroll
                for (int bj = 0; bj < 2; ++bj)
#pragma unroll
                    for (int n = 0; n < 2; ++n) {
                        const int c = col0 + bj * 128 + n * 16;
                        const u32x2 gv = *(const u32x2*)(G + (size_t)r * 2048 + c);
                        f32x4 o = acc[ai][bj][m][n] * rstd;
                        o[0] *= bf_lo(gv.x); o[1] *= bf_hi(gv.x); o[2] *= bf_lo(gv.y); o[3] *= bf_hi(gv.y);
                        *(f32x4*)(PA + (size_t)r * 1024 + c) = o;
                    }
            }
    }
};
struct EpiPB {
    static constexpr bool PERM = false, AFTER_DRAIN = false;
    const float* PA; const bf16_t* G; bf16_t* MB;
    __device__ __forceinline__ void operator()(const f32x4 (&acc)[2][2][4][2], const Unit& u, int wr, int wc, int fr, int fq) const {
        const int row0 = u.pm * 256 + wr * 64 + fr, col0 = u.pn * 256 + wc * 32 + 4 * fq;
#pragma unroll
        for (int ai = 0; ai < 2; ++ai)
#pragma unroll
            for (int m = 0; m < 4; ++m) {
                const int r = row0 + ai * 128 + m * 16;
#pragma unroll
                for (int bj = 0; bj < 2; ++bj)
#pragma unroll
                    for (int n = 0; n < 2; ++n) {
                        const int c = col0 + bj * 128 + n * 16;
                        const u32x2 gv = *(const u32x2*)(G + (size_t)r * 2048 + 1024 + c);
                        f32x4 o = *(const f32x4*)(PA + (size_t)r * 1024 + c); const f32x4 a = acc[ai][bj][m][n];
                        o[0] += a[0] * bf_lo(gv.x); o[1] += a[1] * bf_hi(gv.x); o[2] += a[2] * bf_lo(gv.y); o[3] += a[3] * bf_hi(gv.y);
                        u32x2 w; w.x = pk_bf16(o[0], o[1]); w.y = pk_bf16(o[2], o[3]);
                        *(u32x2*)(MB + (size_t)r * 1024 + c) = w;
                    }
            }
    }
};
struct EpiRes {
    static constexpr bool PERM = false, AFTER_DRAIN = false;
    float* dst; const float* base; const float* xs; const float* POS; const float* gate; int posx;
    __device__ __forceinline__ void operator()(const f32x4 (&acc)[2][2][4][2], const Unit& u, int wr, int wc, int fr, int fq) const {
        const int row0 = u.pm * 256 + wr * 64 + fr, col0 = u.pn * 256 + wc * 32 + 4 * fq;
        const int mi = mod_idx(u.pm * 256); const bool lat = posx && (u.pm * 256 >= NCTX_TOK);
        f32x4 gt[2][2];
#pragma unroll
        for (int bj = 0; bj < 2; ++bj)
#pragma unroll
            for (int n = 0; n < 2; ++n) gt[bj][n] = *(const f32x4*)(gate + (size_t)mi * 6144 + col0 + bj * 128 + n * 16);
#pragma unroll
        for (int ai = 0; ai < 2; ++ai)
#pragma unroll
            for (int m = 0; m < 4; ++m) {
                const int r = row0 + ai * 128 + m * 16;
                const float* bp = lat ? xs + (size_t)(r - NCTX_TOK) * 1024 : base + (size_t)r * 1024;
                const int tt = (r - NCTX_TOK) & 4095;
#pragma unroll
                for (int bj = 0; bj < 2; ++bj)
#pragma unroll
                    for (int n = 0; n < 2; ++n) {
                        const int c = col0 + bj * 128 + n * 16;
                        f32x4 b = *(const f32x4*)(bp + c);
                        if (lat) { const float* pp = c < 512 ? POS + (tt >> 6) * 512 + c : POS + (tt & 63) * 512 + (c - 512); b += *(const f32x4*)pp; }
                        *(f32x4*)(dst + (size_t)r * 1024 + c) = b * DN_ALPHA + gt[bj][n] * acc[ai][bj][m][n];
                    }
            }
    }
};
struct EpiFF1 {
    static constexpr bool PERM = true, AFTER_DRAIN = false;
    bf16_t* FH;
    __device__ __forceinline__ void operator()(const f32x4 (&acc)[2][2][4][2], const Unit& u, int wr, int wc, int fr, int fq) const {
        const int row0 = u.pm * 256 + wr * 64 + fr, col0 = u.pn * 256 + wc * 32 + 8 * fq;
#pragma unroll
        for (int ai = 0; ai < 2; ++ai)
#pragma unroll
            for (int m = 0; m < 4; ++m) {
                bf16_t* rowp = FH + (size_t)(row0 + ai * 128 + m * 16) * DFF + col0;
#pragma unroll
                for (int bj = 0; bj < 2; ++bj) {
                    f32x4 v0 = acc[ai][bj][m][0], v1 = acc[ai][bj][m][1];
#pragma unroll
                    for (int j = 0; j < 4; ++j) { const float a = fmaxf(v0[j], 0.f), b = fmaxf(v1[j], 0.f); v0[j] = a * a; v1[j] = b * b; }
                    u32x4 w; w.x = pk_bf16(v0[0], v0[1]); w.y = pk_bf16(v0[2], v0[3]); w.z = pk_bf16(v1[0], v1[1]); w.w = pk_bf16(v1[2], v1[3]);
                    *(u32x4*)(rowp + bj * 128) = w;
                }
            }
    }
};

struct Ctx {
    const float* in[30]; float* out; uchar* ws; LAS uchar* lds; int tid, lane, wave, G, bid;
};
#define WSP(T, off) ((T*)(C.ws + (off)))

__device__ __forceinline__ void transpose_item(const float* W, int K, int N, bf16_t* WT, int item, int lane, LAS float* scr, bool remap_in) {
    const int nblk = N / 32, kb = item / nblk, nb = item % nblk, k0 = 64 * kb, n0 = 32 * nb;
#pragma unroll 8
    for (int i = 0; i < 32; ++i) { const int kk = 2 * i + (lane >> 5); scr[kk * 33 + (lane & 31)] = W[(size_t)(k0 + kk) * N + n0 + (lane & 31)]; }
    asm volatile("s_waitcnt lgkmcnt(0)" ::: "memory");
    int d0 = n0;
    if (remap_in) d0 = n0 < 2560 ? n0 : (n0 < 2592 ? 6656 + (n0 - 2560) : n0 - 32);
    const int c = lane & 7;
#pragma unroll
    for (int j = 0; j < 4; ++j) { const int n = (lane >> 3) + 8 * j; const LAS float* s = scr + (8 * c) * 33 + n;
        u32x4 o; o.x = pk_bf16(s[0 * 33], s[1 * 33]); o.y = pk_bf16(s[2 * 33], s[3 * 33]); o.z = pk_bf16(s[4 * 33], s[5 * 33]); o.w = pk_bf16(s[6 * 33], s[7 * 33]);
        *(u32x4*)(WT + (size_t)(d0 + n) * K + k0 + 8 * c) = o; }
    asm volatile("s_waitcnt lgkmcnt(0)" ::: "memory");
}
__device__ __forceinline__ void phase0(Ctx& C) {
    {
        LAS float* sv = (LAS float*)C.lds;
        bool have = false;
        for (int it = C.bid; it < 192; it += C.G) {
            if (!have) {
                for (int i = C.tid; i < 3072; i += NTHREADS) { const int m = i >> 10, k = i & 1023; const float v = m == 0 ? C.in[5][k] : C.in[4][(m - 1) * 1024 + k]; sv[i] = siluf_(v); }
                __syncthreads(); have = true;
            }
            const int cgp = it % 12, ks = it / 12, col = cgp * 512 + C.tid;
            const float* w = C.in[6] + (size_t)(ks * 64) * 6144 + col;
            float a0 = 0.f, a1 = 0.f, a2 = 0.f;
#pragma unroll 8
            for (int k = 0; k < 64; ++k) { const float wv = w[(size_t)k * 6144]; const int kk = ks * 64 + k; a0 += sv[kk] * wv; a1 += sv[1024 + kk] * wv; a2 += sv[2048 + kk] * wv; }
            if (ks == 0) { const float b = C.in[7][col]; a0 += b; a1 += b; a2 += b; }
            float* mp = WSP(float, OFF_MODP) + (size_t)ks * 18432 + col;
            mp[0] = a0; mp[6144] = a1; mp[12288] = a2;
        }
        __syncthreads();
    }
    {
        LAS float* scr = (LAS float*)(C.lds + C.wave * 8448);
        const int gw = C.bid * 8 + C.wave, NGW = C.G * 8;
        constexpr int I_IN = 16 * 209, I_SQ = 16 * 32, I_F1 = 16 * 128, I_F2 = 64 * 32;
        constexpr int NIT = I_IN + 3 * I_SQ + I_F1 + I_F2;
        for (int it = gw; it < NIT; it += NGW) {
            int r = it;
            if (r < I_IN) { transpose_item(C.in[8], 1024, 6688, WSP(bf16_t, OFF_WIN), r, C.lane, scr, true); continue; } r -= I_IN;
            if (r < I_SQ) { transpose_item(C.in[21], 1024, 1024, WSP(bf16_t, OFF_WPA), r, C.lane, scr, false); continue; } r -= I_SQ;
            if (r < I_SQ) { transpose_item(C.in[22], 1024, 1024, WSP(bf16_t, OFF_WPB), r, C.lane, scr, false); continue; } r -= I_SQ;
            if (r < I_SQ) { transpose_item(C.in[23], 1024, 1024, WSP(bf16_t, OFF_WOUT), r, C.lane, scr, false); continue; } r -= I_SQ;
            if (r < I_F1) { transpose_item(C.in[26], 1024, 4096, WSP(bf16_t, OFF_WFF1), r, C.lane, scr, false); continue; } r -= I_F1;
            transpose_item(C.in[27], 4096, 1024, WSP(bf16_t, OFF_WFF2), r, C.lane, scr, false);
        }
    }
    const int gt = C.bid * NTHREADS + C.tid, NGT = C.G * NTHREADS;
    { const f32x4* s = (const f32x4*)C.in[19]; u32x2* d = WSP(u32x2, OFF_WSP); for (int i = gt; i < 131072 / 4; i += NGT) { const f32x4 v = s[i]; d[i] = (u32x2){pk_bf16(v[0], v[1]), pk_bf16(v[2], v[3])}; } }
    { float* P = WSP(float, OFF_POS); for (int i = gt; i < 64 * 512; i += NGT) { const int r = i >> 9, c = i & 511, q = c & 255;
        const float omega = exp2f(-(float)q * (13.287712379549449f / 256.0f)); const float ang = (float)r * omega; P[i] = c < 256 ? sinf(ang) : cosf(ang); } }
}

__device__ __forceinline__ void phase1(Ctx& C) {
    LAS float* ml = (LAS float*)C.lds;
    LAS uchar* HR = C.lds + 24576;
    constexpr int HP = 2064;
    const float* MODP = WSP(float, OFF_MODP);
    for (int i = C.tid; i < 6144; i += NTHREADS) { const int m = i >> 11, c = i & 2047; float s = 0.f;
#pragma unroll
        for (int ks = 0; ks < 16; ++ks) s += MODP[(size_t)ks * 18432 + m * 6144 + c];
        ml[i] = s; }
    if (C.bid < 36) { const int i = C.bid * 512 + C.tid; float s = 0.f;
#pragma unroll
        for (int ks = 0; ks < 16; ++ks) s += MODP[(size_t)ks * 18432 + i];
        WSP(float, OFF_MOD)[i] = s; }
    __syncthreads();
    const float* POS = WSP(float, OFF_POS); bf16_t* H1 = WSP(bf16_t, OFF_H1); const bf16_t* WDT = WSP(bf16_t, OFF_WIN) + (size_t)6656 * 1024; float* DT = WSP(float, OFF_DT);
    for (int rg = C.bid; rg < MT / 48; rg += C.G) {
        const int R0 = rg * 48;
#pragma unroll 2
        for (int k = 0; k < 6; ++k) { const int lr = 6 * C.wave + k, t = R0 + lr;
            const bool lat = t >= NCTX_TOK; const int mi = mod_idx(t), tt = (t - NCTX_TOK) & 4095;
            const float* xr = lat ? C.in[1] + (size_t)(t - NCTX_TOK) * 1024 : C.in[0] + (size_t)t * 1024;
#pragma unroll
            for (int j = 0; j < 4; ++j) { const int c = 4 * C.lane + 256 * j; f32x4 v = *(const f32x4*)(xr + c);
                if (lat) { const float* pp = c < 512 ? POS + (tt >> 6) * 512 + c : POS + (tt & 63) * 512 + (c - 512); v += *(const f32x4*)pp; }
                const f32x4 sh = *(const LAS f32x4*)(ml + mi * 2048 + c), sc = *(const LAS f32x4*)(ml + mi * 2048 + 1024 + c);
                v = v * (sc + 1.0f) + sh;
                const u32x2 pk = (u32x2){pk_bf16(v[0], v[1]), pk_bf16(v[2], v[3])};
                *(u32x2*)(H1 + (size_t)t * 1024 + c) = pk; *(LAS u32x2*)(HR + lr * HP + c * 2) = pk; } }
        __syncthreads();
        const int rt = C.wave & 1, kq = C.wave >> 1, r = C.lane & 31, hh = C.lane >> 5;
        f32x16 acc = {0};
        { const int ar = (rt * 32 + r) < 48 ? (rt * 32 + r) : 47; const LAS uchar* pa = HR + ar * HP + (kq * 256 + 8 * hh) * 2; const bf16_t* pb = WDT + (size_t)r * 1024 + kq * 256 + 8 * hh;
#pragma unroll
          for (int ks = 0; ks < 16; ++ks) { const bf16x8 av = *(const LAS bf16x8*)(pa + ks * 32); const bf16x8 bv = *(const bf16x8*)(pb + ks * 16); acc = __builtin_amdgcn_mfma_f32_32x32x16_bf16(av, bv, acc, 0, 0, 0); } }
        __syncthreads();
        LAS float* scr = (LAS float*)HR;
#pragma unroll
        for (int e = 0; e < 16; ++e) scr[(C.wave * 16 + e) * 64 + C.lane] = acc[e];
        __syncthreads();
#pragma unroll
        for (int q = 0; q < 3; ++q) { const int idx = C.tid + 512 * q, row = idx >> 5, col = idx & 31, rt2 = row >> 5, rr = row & 31, h2 = (rr >> 2) & 1, e = (rr & 3) + 4 * (rr >> 3), ln = col + 32 * h2; float s = 0.f;
#pragma unroll
            for (int k4 = 0; k4 < 4; ++k4) s += scr[((k4 * 2 + rt2) * 16 + e) * 64 + ln];
            s += col < 16 ? C.in[11][col] : C.in[12][col - 16];
            DT[(size_t)(R0 + row) * 32 + col] = softplusf_(s); }
        __syncthreads();
    }
}

constexpr int PITCH = 272;
__device__ __forceinline__ int rowmap(int e, int hh) { return (e & 3) + 8 * (e >> 2) + 4 * hh; }
__device__ __forceinline__ f32x16 mma_k128(const LAS uchar* A, const LAS uchar* B, int lane, f32x16 acc) {
    const int r = lane & 31, hh = lane >> 5; const LAS uchar* pa = A + r * PITCH + hh * 16; const LAS uchar* pb = B + r * PITCH + hh * 16;
#pragma unroll
    for (int ks = 0; ks < 8; ++ks) { const bf16x8 a = *(const LAS bf16x8*)(pa + ks * 32); const bf16x8 b = *(const LAS bf16x8*)(pb + ks * 32); acc = __builtin_amdgcn_mfma_f32_32x32x16_bf16(a, b, acc, 0, 0, 0); }
    return acc;
}
struct CW { f32x4 w0a, w0b, w1a, w1b, w2a, w2b, ba, bb; };
__device__ __forceinline__ CW load_cw(const float* cw, const float* cb, int ch) {
    CW w; w.w0a = *(const f32x4*)(cw + ch); w.w0b = *(const f32x4*)(cw + ch + 4); w.w1a = *(const f32x4*)(cw + 1536 + ch); w.w1b = *(const f32x4*)(cw + 1536 + ch + 4);
    w.w2a = *(const f32x4*)(cw + 3072 + ch); w.w2b = *(const f32x4*)(cw + 3072 + ch + 4); w.ba = *(const f32x4*)(cb + ch); w.bb = *(const f32x4*)(cb + ch + 4); return w;
}
__device__ __forceinline__ u32x4 ld_tok(const bf16_t* XBC, int t, int t0, int t1, int ch) {
    return (t >= t0 && t < t1) ? *(const u32x4*)(XBC + (size_t)t * 1536 + ch) : (u32x4){0u, 0u, 0u, 0u};
}
__device__ __forceinline__ void conv3_silu(const u32x4 vm, const u32x4 v0, const u32x4 vp, const CW& w, float (&o)[8]) {
    float xm[8], x0[8], xp[8]; unpack8(vm, xm); unpack8(v0, x0); unpack8(vp, xp);
#pragma unroll
    for (int e = 0; e < 4; ++e) { o[e] = siluf_(w.w0a[e] * xm[e] + w.w1a[e] * x0[e] + w.w2a[e] * xp[e] + w.ba[e]); o[4 + e] = siluf_(w.w0b[e] * xm[4 + e] + w.w1b[e] * x0[4 + e] + w.w2b[e] * xp[4 + e] + w.bb[e]); }
}
__device__ __forceinline__ u32x4 pack8(const float (&y)[8]) { return (u32x4){pk_bf16(y[0], y[1]), pk_bf16(y[2], y[3]), pk_bf16(y[4], y[5]), pk_bf16(y[6], y[7])}; }
struct CW4 { f32x4 w0, w1, w2, b; };
__device__ __forceinline__ CW4 load_cw4(const float* cw, const float* cb, int ch) { CW4 w; w.w0 = *(const f32x4*)(cw + ch); w.w1 = *(const f32x4*)(cw + 1536 + ch); w.w2 = *(const f32x4*)(cw + 3072 + ch); w.b = *(const f32x4*)(cb + ch); return w; }
__device__ __forceinline__ u32x2 ld_tok4(const bf16_t* XBC, int t, int t0, int t1, int ch) { return (t >= t0 && t < t1) ? *(const u32x2*)(XBC + (size_t)t * 1536 + ch) : (u32x2){0u, 0u}; }
__device__ __forceinline__ u32x2 conv3_silu4(const u32x2 vm, const u32x2 v0, const u32x2 vp, const CW4& w) {
    const float xm[4] = {bf_lo(vm.x), bf_hi(vm.x), bf_lo(vm.y), bf_hi(vm.y)}, x0[4] = {bf_lo(v0.x), bf_hi(v0.x), bf_lo(v0.y), bf_hi(v0.y)}, xp[4] = {bf_lo(vp.x), bf_hi(vp.x), bf_lo(vp.y), bf_hi(vp.y)};
    float o[4];
#pragma unroll
    for (int e = 0; e < 4; ++e) o[e] = siluf_(w.w0[e] * xm[e] + w.w1[e] * x0[e] + w.w2[e] * xp[e] + w.b[e]);
    return (u32x2){pk_bf16(o[0], o[1]), pk_bf16(o[2], o[3])};
}
struct LaneScal { float df0, df1, db0, db1, af0, af1, ab0, ab1, totF, totB; };
__device__ __forceinline__ LaneScal lane_scalars(float df0, float df1, float db0, float db1, float anf, float anb, int lane) {
    LaneScal s; s.df0 = df0; s.df1 = df1; s.db0 = db0; s.db1 = db1;
    const float f0 = df0 * anf, f1 = df1 * anf, b0 = db0 * anb, b1 = db1 * anb;
    float sf = f0 + f1, sb = b0 + b1;
#pragma unroll
    for (int o = 1; o < 64; o <<= 1) { const float tf = __shfl_up(sf, o), tb = __shfl_up(sb, o); if (lane >= o) { sf += tf; sb += tb; } }
    s.totF = __shfl(sf, 63); s.totB = __shfl(sb, 63);
    s.af0 = sf - f1; s.af1 = sf; s.ab0 = s.totB - (sb - b0 - b1); s.ab1 = s.totB - (sb - b1);
    return s;
}

__device__ __forceinline__ void ssd_states_item(Ctx& C, int item) {
    const int chunk = item >> 4, h = item & 15, g = h >> 3, tok0 = chunk * 128; int t0, t1; seq_bounds(chunk, t0, t1);
    LAS uchar* BT = C.lds; LAS uchar* XTF = C.lds + 34816; LAS uchar* XTB = C.lds + 52224;
    const bf16_t* XBC = WSP(bf16_t, OFF_XBC); const float* cw = C.in[9]; const float* cb = C.in[10];
    const int pair = C.lane, ta = tok0 + 2 * pair;
    const float* DT = WSP(float, OFF_DT) + (size_t)ta * 32;
    const float df0 = DT[h], df1 = DT[32 + h], db0 = DT[16 + h], db1 = DT[48 + h];
    const float alf = C.in[13][h], alb = C.in[14][h];
    const int chx = h * 64 + C.wave * 8, chb0 = 1024 + g * 128 + C.wave * 8, chb1 = chb0 + 64;
    const u32x4 x_m = ld_tok(XBC, ta - 1, t0, t1, chx), x_a = ld_tok(XBC, ta, t0, t1, chx), x_b = ld_tok(XBC, ta + 1, t0, t1, chx), x_p = ld_tok(XBC, ta + 2, t0, t1, chx);
    const u32x4 p_m = ld_tok(XBC, ta - 1, t0, t1, chb0), p_a = ld_tok(XBC, ta, t0, t1, chb0), p_b = ld_tok(XBC, ta + 1, t0, t1, chb0), p_p = ld_tok(XBC, ta + 2, t0, t1, chb0);
    const u32x4 q_m = ld_tok(XBC, ta - 1, t0, t1, chb1), q_a = ld_tok(XBC, ta, t0, t1, chb1), q_b = ld_tok(XBC, ta + 1, t0, t1, chb1), q_p = ld_tok(XBC, ta + 2, t0, t1, chb1);
    const CW wx = load_cw(cw, cb, chx), wb0 = load_cw(cw, cb, chb0), wb1 = load_cw(cw, cb, chb1);
    const LaneScal s = lane_scalars(df0, df1, db0, db1, -__expf(alf), -__expf(alb), C.lane);
    const float wf0 = s.df0 * __expf(s.totF - s.af0), wf1 = s.df1 * __expf(s.totF - s.af1), wbk0 = s.db0 * __expf(s.totB - s.ab0), wbk1 = s.db1 * __expf(s.totB - s.ab1);
    if (C.tid == 0) { float* AL = WSP(float, OFF_AL) + (size_t)(chunk * 16 + h) * 2; AL[0] = s.totF; AL[1] = s.totB; }
    { float y0[8], y1[8]; conv3_silu(p_m, p_a, p_b, wb0, y0); conv3_silu(p_a, p_b, p_p, wb0, y1);
#pragma unroll
      for (int e = 0; e < 8; ++e) *(LAS unsigned*)(BT + (C.wave * 8 + e) * PITCH + pair * 4) = pk_bf16(y0[e], y1[e]);
      conv3_silu(q_m, q_a, q_b, wb1, y0); conv3_silu(q_a, q_b, q_p, wb1, y1);
#pragma unroll
      for (int e = 0; e < 8; ++e) *(LAS unsigned*)(BT + ((C.wave + 8) * 8 + e) * PITCH + pair * 4) = pk_bf16(y0[e], y1[e]);
      conv3_silu(x_m, x_a, x_b, wx, y0); conv3_silu(x_a, x_b, x_p, wx, y1);
#pragma unroll
      for (int e = 0; e < 8; ++e) { *(LAS unsigned*)(XTF + (C.wave * 8 + e) * PITCH + pair * 4) = pk_bf16(y0[e] * wf0, y1[e] * wf1); *(LAS unsigned*)(XTB + (C.wave * 8 + e) * PITCH + pair * 4) = pk_bf16(y0[e] * wbk0, y1[e] * wbk1); } }
    __syncthreads();
    { const int dir = C.wave >> 2, tn = C.wave & 3; const LAS uchar* XT = dir ? XTB : XTF;
        f32x16 a0 = {0}, a1 = {0};
        a0 = mma_k128(XT, BT + tn * 32 * PITCH, C.lane, a0); a1 = mma_k128(XT + 32 * PITCH, BT + tn * 32 * PITCH, C.lane, a1);
        bf16_t* ST = WSP(bf16_t, OFF_ST) + ((size_t)(chunk * 16 + h) * 2 + dir) * 8192; const int n = tn * 32 + (C.lane & 31), hh = C.lane >> 5;
#pragma unroll
        for (int e = 0; e < 16; ++e) { const int p = rowmap(e, hh); ST[p * 128 + n] = to_bf1(a0[e]); ST[(32 + p) * 128 + n] = to_bf1(a1[e]); } }
    __syncthreads();
}

__device__ __forceinline__ void sgu_stats(Ctx& C) {
    f32x2* ST2 = WSP(f32x2, OFF_MODP);
    for (int t = C.bid * NTHREADS + C.tid; t < MT; t += C.G * NTHREADS) { const f32x4* vs = (const f32x4*)(WSP(float, OFF_VSTAT) + (size_t)t * 32); float s = 0.f, ss = 0.f;
#pragma unroll
        for (int k = 0; k < 8; ++k) { const f32x4 v = vs[k]; s += v[0] + v[2]; ss += v[1] + v[3]; }
        const float mu = s * (1.0f / 1024.0f), var = fmaxf(ss * (1.0f / 1024.0f) - mu * mu, 0.f); ST2[t] = (f32x2){mu, rsqrtf(var + EPS)}; }
}

__device__ __forceinline__ void sgu_item(Ctx& C, int item) {
    const int chunk = item >> 3, g = item & 7, tok0 = chunk * 128;
    LAS uchar* WS_ = C.lds; LAS uchar* VT = C.lds + 34816;
    const bf16_t* V = WSP(bf16_t, OFF_V); const f32x2* ST2 = WSP(f32x2, OFF_MODP);
    const int pair = C.lane, ta = tok0 + 2 * pair, d0 = g * 128 + C.wave * 8, d1 = d0 + 64;
    const int ti = C.wave >> 1, td0 = (C.wave & 1) * 2, hh = C.lane >> 5, l31 = C.lane & 31;
    const f32x2 sta = ST2[ta], stb = ST2[ta + 1];
    const u32x4 va0 = *(const u32x4*)(V + (size_t)ta * 1024 + d0), vb0 = *(const u32x4*)(V + (size_t)(ta + 1) * 1024 + d0), va1 = *(const u32x4*)(V + (size_t)ta * 1024 + d1), vb1 = *(const u32x4*)(V + (size_t)(ta + 1) * 1024 + d1);
    const f32x4 g0a = *(const f32x4*)(C.in[17] + d0), g0b = *(const f32x4*)(C.in[17] + d0 + 4), b0a = *(const f32x4*)(C.in[18] + d0), b0b = *(const f32x4*)(C.in[18] + d0 + 4);
    const f32x4 g1a = *(const f32x4*)(C.in[17] + d1), g1b = *(const f32x4*)(C.in[17] + d1 + 4), b1a = *(const f32x4*)(C.in[18] + d1), b1b = *(const f32x4*)(C.in[18] + d1 + 4);
    const u32x4* src = (const u32x4*)(WSP(bf16_t, OFF_WSP) + (size_t)g * 16384);
    u32x4 wv[4];
#pragma unroll
    for (int k = 0; k < 4; ++k) wv[k] = src[C.tid + 512 * k];
    bf16_t* U = (bf16_t*)(C.out + 4194304);
    bf16_t uv[2][16]; float bs[16];
#pragma unroll
    for (int e = 0; e < 16; ++e) { const int i = ti * 32 + rowmap(e, hh); bs[e] = C.in[20][g * 128 + i];
#pragma unroll
        for (int q = 0; q < 2; ++q) uv[q][e] = U[(size_t)(tok0 + i) * 1024 + g * 128 + (td0 + q) * 32 + l31]; }
#pragma unroll
    for (int k = 0; k < 4; ++k) { const int v = C.tid + 512 * k, i = v >> 4, c8 = v & 15; *(LAS u32x4*)(WS_ + i * PITCH + c8 * 16) = wv[k]; }
    { float xa[8], xb[8]; unpack8(va0, xa); unpack8(vb0, xb);
#pragma unroll
      for (int e = 0; e < 8; ++e) { const float gg = e < 4 ? g0a[e & 3] : g0b[e & 3], bb = e < 4 ? b0a[e & 3] : b0b[e & 3];
          *(LAS unsigned*)(VT + (C.wave * 8 + e) * PITCH + pair * 4) = pk_bf16((xa[e] - sta[0]) * sta[1] * gg + bb, (xb[e] - stb[0]) * stb[1] * gg + bb); }
      unpack8(va1, xa); unpack8(vb1, xb);
#pragma unroll
      for (int e = 0; e < 8; ++e) { const float gg = e < 4 ? g1a[e & 3] : g1b[e & 3], bb = e < 4 ? b1a[e & 3] : b1b[e & 3];
          *(LAS unsigned*)(VT + ((C.wave + 8) * 8 + e) * PITCH + pair * 4) = pk_bf16((xa[e] - sta[0]) * sta[1] * gg + bb, (xb[e] - stb[0]) * stb[1] * gg + bb); } }
    __syncthreads();
#pragma unroll
    for (int q = 0; q < 2; ++q) { f32x16 acc = {0}; acc = mma_k128(WS_ + ti * 32 * PITCH, VT + (td0 + q) * 32 * PITCH, C.lane, acc);
#pragma unroll
        for (int e = 0; e < 16; ++e) { const int i = ti * 32 + rowmap(e, hh); U[(size_t)(tok0 + i) * 1024 + g * 128 + (td0 + q) * 32 + l31] = to_bf1(bf1(uv[q][e]) * (acc[e] + bs[e])); } }
    __syncthreads();
}

template <int NB> __device__ __forceinline__ void scan_steps(bf16_t* STb, const float* ALb, int c0, int nc, int dir, int k0, float (&hv)[4]) {
    u32x2 sv[NB]; float dec[NB]; u32x2* pp[NB];
#pragma unroll
    for (int k = 0; k < NB; ++k) { const int c = c0 + (dir ? nc - 1 - (k0 + k) : (k0 + k)); pp[k] = (u32x2*)(STb + (size_t)c * 16 * 2 * 8192); sv[k] = *pp[k]; dec[k] = ALb[(size_t)c * 32]; }
#pragma unroll
    for (int k = 0; k < NB; ++k) { const float d = __expf(dec[k]); *pp[k] = (u32x2){pk_bf16(hv[0], hv[1]), pk_bf16(hv[2], hv[3])};
        hv[0] = d * hv[0] + bf_lo(sv[k].x); hv[1] = d * hv[1] + bf_hi(sv[k].x); hv[2] = d * hv[2] + bf_lo(sv[k].y); hv[3] = d * hv[3] + bf_hi(sv[k].y); }
}
__device__ __forceinline__ void scan_item(Ctx& C, int item) {
    int seq, nc, c0; int r = item;
    if (r < 256) { seq = 16 + (r >> 7); r &= 127; nc = 32; c0 = 32 + (seq - 16) * 32; } else { r -= 256; seq = r >> 7; r &= 127; nc = 2; c0 = seq * 2; }
    const int h = r >> 3, dir = (r >> 2) & 1, quarter = r & 3; const int e0 = quarter * 2048 + C.tid * 4;
    float hv[4];
    if (seq >= 16) { const f32x4 v = *(const f32x4*)((dir ? C.in[3] : C.in[2]) + ((size_t)(seq - 16) * 16 + h) * 8192 + e0); hv[0] = v[0]; hv[1] = v[1]; hv[2] = v[2]; hv[3] = v[3]; } else { hv[0] = hv[1] = hv[2] = hv[3] = 0.f; }
    bf16_t* STb = WSP(bf16_t, OFF_ST) + ((size_t)h * 2 + dir) * 8192 + e0; const float* ALb = WSP(float, OFF_AL) + h * 2 + dir;
    if (nc == 32) { for (int k0 = 0; k0 < 32; k0 += 8) scan_steps<8>(STb, ALb, c0, nc, dir, k0, hv); } else scan_steps<2>(STb, ALb, c0, nc, dir, 0, hv);
    if (seq < 16) *(f32x4*)(C.out + 12582912 + (size_t)dir * 2097152 + ((size_t)seq * 16 + h) * 8192 + e0) = (f32x4){hv[0], hv[1], hv[2], hv[3]};
}

__device__ __forceinline__ void ssd_out_item(Ctx& C, int item) {
    const int chunk = item >> 4, h = item & 15, g = h >> 3, tok0 = chunk * 128; int t0, t1; seq_bounds(chunk, t0, t1);
    LAS uchar* CN = C.lds; LAS uchar* BN = C.lds + 34816; LAS uchar* XT = C.lds + 69632; LAS uchar* HF = C.lds + 87040; LAS uchar* HB = C.lds + 104448;
    LAS f32x4* SC = (LAS f32x4*)(C.lds + 121856);
    const bf16_t* XBC = WSP(bf16_t, OFF_XBC); const float* cw = C.in[9]; const float* cb = C.in[10];
    const int hh = C.lane >> 5, c = C.lane & 31, ti = C.wave >> 1, tp = C.wave & 1, i = ti * 32 + c;
    const int oc4 = C.tid & 31, jq = C.tid >> 5, tq = tok0 + 8 * jq, chc = 1280 + g * 128 + oc4 * 4, chb = 1024 + g * 128 + oc4 * 4;
    u32x2 rc[10], rb[10];
#pragma unroll
    for (int k = 0; k < 10; ++k) { rc[k] = ld_tok4(XBC, tq - 1 + k, t0, t1, chc); rb[k] = ld_tok4(XBC, tq - 1 + k, t0, t1, chb); }
    const int pair = C.lane, ta = tok0 + 2 * pair, chx = h * 64 + C.wave * 8;
    const u32x4 x_m = ld_tok(XBC, ta - 1, t0, t1, chx), x_a = ld_tok(XBC, ta, t0, t1, chx), x_b = ld_tok(XBC, ta + 1, t0, t1, chx), x_p = ld_tok(XBC, ta + 2, t0, t1, chx);
    const u32x4* hs = (const u32x4*)(WSP(bf16_t, OFF_ST) + (size_t)(chunk * 16 + h) * 2 * 8192);
    const u32x4 hf0 = hs[C.tid], hf1 = hs[C.tid + 512], hb0 = hs[1024 + C.tid], hb1 = hs[1536 + C.tid];
    const float* DT = WSP(float, OFF_DT) + (size_t)ta * 32;
    const float df0 = DT[h], df1 = DT[32 + h], db0 = DT[16 + h], db1 = DT[48 + h];
    const float alf = C.in[13][h], alb = C.in[14][h];
    const CW4 wc = load_cw4(cw, cb, chc), wb = load_cw4(cw, cb, chb);
    bf16_t* zrow = WSP(bf16_t, OFF_ZS) + (size_t)(tok0 + i) * 1024 + h * 64 + tp * 32 + 4 * hh;
    u32x2 zq[4];
#pragma unroll
    for (int q = 0; q < 4; ++q) zq[q] = *(const u32x2*)(zrow + 8 * q);
    const float dsk = C.in[15][h];
    if (C.wave == 0) { const LaneScal s = lane_scalars(df0, df1, db0, db1, -__expf(alf), -__expf(alb), C.lane); const int j0 = 2 * C.lane;
        SC[j0] = (f32x4){s.af0, s.ab0, df0, db0}; SC[j0 + 1] = (f32x4){s.af1, s.ab1, df1, db1}; }
    {
#pragma unroll
      for (int k = 0; k < 8; ++k) { *(LAS u32x2*)(CN + (8 * jq + k) * PITCH + oc4 * 8) = conv3_silu4(rc[k], rc[k + 1], rc[k + 2], wc);
                                    *(LAS u32x2*)(BN + (8 * jq + k) * PITCH + oc4 * 8) = conv3_silu4(rb[k], rb[k + 1], rb[k + 2], wb); }
      asm volatile("" ::: "memory");
      const CW wx = load_cw(cw, cb, chx);
      float y0[8], y1[8]; conv3_silu(x_m, x_a, x_b, wx, y0); conv3_silu(x_a, x_b, x_p, wx, y1);
#pragma unroll
      for (int e = 0; e < 8; ++e) *(LAS unsigned*)(XT + (C.wave * 8 + e) * PITCH + pair * 4) = pk_bf16(y0[e], y1[e]); }
    { const int p0 = C.tid >> 4, c8 = C.tid & 15; *(LAS u32x4*)(HF + p0 * PITCH + c8 * 16) = hf0; *(LAS u32x4*)(HF + (p0 + 32) * PITCH + c8 * 16) = hf1; *(LAS u32x4*)(HB + p0 * PITCH + c8 * 16) = hb0; *(LAS u32x4*)(HB + (p0 + 32) * PITCH + c8 * 16) = hb1; }
    __syncthreads();
    const f32x4 sci = SC[i]; const float AFi = sci[0], ABi = sci[1];
    f32x16 ad = {0}, af = {0}, ab = {0};
    af = mma_k128(HF + tp * 32 * PITCH, CN + ti * 32 * PITCH, C.lane, af);
    ab = mma_k128(HB + tp * 32 * PITCH, CN + ti * 32 * PITCH, C.lane, ab);
    const LAS uchar* xrow = XT + (tp * 32 + c) * PITCH + 8 * hh;
#pragma unroll
    for (int tj = 0; tj < 4; ++tj) {
        f32x16 X = {0}; X = mma_k128(BN + tj * 32 * PITCH, CN + ti * 32 * PITCH, C.lane, X);
#pragma unroll
        for (int e = 0; e < 16; ++e) { const int j = tj * 32 + rowmap(e, hh); const f32x4 scj = SC[j]; float w = 0.f;
            if (j <= i) w += __expf(AFi - scj[0]) * scj[2];
            if (j >= i) w += __expf(ABi - scj[1]) * scj[3];
            X[e] = X[e] * w + (i == j ? dsk : 0.f); }
#pragma unroll
        for (int s = 0; s < 2; ++s) {
            const u32x4 bw = (u32x4){pk_bf16(X[8 * s], X[8 * s + 1]), pk_bf16(X[8 * s + 2], X[8 * s + 3]), pk_bf16(X[8 * s + 4], X[8 * s + 5]), pk_bf16(X[8 * s + 6], X[8 * s + 7])};
            const u32x2 a_lo = *(const LAS u32x2*)(xrow + (tj * 32 + 16 * s) * 2), a_hi = *(const LAS u32x2*)(xrow + (tj * 32 + 16 * s) * 2 + 16);
            const u32x4 aw = (u32x4){a_lo.x, a_lo.y, a_hi.x, a_hi.y};
            ad = __builtin_amdgcn_mfma_f32_32x32x16_bf16(__builtin_bit_cast(bf16x8, aw), __builtin_bit_cast(bf16x8, bw), ad, 0, 0, 0);
        }
    }
    {
        const float ef = __expf(AFi), eb = __expf(ABi); float ss = 0.f;
#pragma unroll
        for (int q = 0; q < 4; ++q) { const f32x4 nw = *(const f32x4*)(C.in[16] + h * 64 + tp * 32 + 8 * q + 4 * hh);
            const float z[4] = {bf_lo(zq[q].x), bf_hi(zq[q].x), bf_lo(zq[q].y), bf_hi(zq[q].y)}; float o[4];
#pragma unroll
            for (int k = 0; k < 4; ++k) { const int e = 4 * q + k; const float y = ad[e] + ef * af[e] + eb * ab[e]; const float gz = y * z[k]; ss += gz * gz; o[k] = gz * nw[k]; }
            *(u32x2*)(zrow + 8 * q) = (u32x2){pk_bf16(o[0], o[1]), pk_bf16(o[2], o[3])}; }
        ss += __shfl_xor(ss, 32);
        if (hh == 0) WSP(float, OFF_SSQ)[(size_t)(tok0 + i) * 32 + h * 2 + tp] = ss;
    }
    __syncthreads();
}

__device__ __forceinline__ void ln1_pass(Ctx& C) {
    float* R1 = WSP(float, OFF_XBC); bf16_t* H2 = WSP(bf16_t, OFF_ZS); const float* MOD = WSP(float, OFF_MOD);
    const int gw = C.bid * 8 + C.wave, NGW = C.G * 8;
    for (int t = gw; t < MT; t += NGW) { const int mi = mod_idx(t); float* rp = R1 + (size_t)t * 1024; f32x4 v[4]; float s = 0.f;
#pragma unroll
        for (int j = 0; j < 4; ++j) { v[j] = *(const f32x4*)(rp + 4 * C.lane + 256 * j); s += (v[j][0] + v[j][1]) + (v[j][2] + v[j][3]); }
        const float mean = wave_sum(s) * (1.0f / 1024.0f); float q = 0.f;
#pragma unroll
        for (int j = 0; j < 4; ++j) { v[j] = v[j] - mean; q += (v[j][0] * v[j][0] + v[j][1] * v[j][1]) + (v[j][2] * v[j][2] + v[j][3] * v[j][3]); }
        const float rstd = rsqrtf(wave_sum(q) * (1.0f / 1024.0f) + EPS);
#pragma unroll
        for (int j = 0; j < 4; ++j) { const int c = 4 * C.lane + 256 * j; const f32x4 x1 = v[j] * rstd * *(const f32x4*)(C.in[24] + c) + *(const f32x4*)(C.in[25] + c);
            *(f32x4*)(rp + c) = x1;
            const f32x4 hv = x1 * (*(const f32x4*)(MOD + mi * 6144 + 4096 + c) + 1.0f) + *(const f32x4*)(MOD + mi * 6144 + 3072 + c);
            *(u32x2*)(H2 + (size_t)t * 1024 + c) = (u32x2){pk_bf16(hv[0], hv[1]), pk_bf16(hv[2], hv[3])}; }
    }
}
__device__ __forceinline__ void ln2_pass(Ctx& C) {
    const int gw = C.bid * 8 + C.wave, NGW = C.G * 8;
    for (int t = gw; t < MT; t += NGW) { float* rp = C.out + (size_t)t * 1024; f32x4 v[4]; float s = 0.f;
#pragma unroll
        for (int j = 0; j < 4; ++j) { v[j] = *(const f32x4*)(rp + 4 * C.lane + 256 * j); s += (v[j][0] + v[j][1]) + (v[j][2] + v[j][3]); }
        const float mean = wave_sum(s) * (1.0f / 1024.0f); float q = 0.f;
#pragma unroll
        for (int j = 0; j < 4; ++j) { v[j] = v[j] - mean; q += (v[j][0] * v[j][0] + v[j][1] * v[j][1]) + (v[j][2] * v[j][2] + v[j][3] * v[j][3]); }
        const float rstd = rsqrtf(wave_sum(q) * (1.0f / 1024.0f) + EPS);
#pragma unroll
        for (int j = 0; j < 4; ++j) { const int c = 4 * C.lane + 256 * j; *(f32x4*)(rp + c) = v[j] * rstd * *(const f32x4*)(C.in[28] + c) + *(const f32x4*)(C.in[29] + c); }
    }
}

#define XB_TMO      128
#define XB_XCNT(j)  (256  + 64 * (j))
#define XB_XSUB(j)  (1280 + 64 * (j))
#define XB_XGEN(j)  (2304 + 64 * (j))
#define XB_TOP      3328
#define XB_TOPGEN   3392
#define XCD_BAR_WORDS 3456
#define XB_SPIN_CAP (1u << 18)

__device__ __forceinline__ unsigned xb_ld(unsigned* p)              { return __hip_atomic_load(p, __ATOMIC_RELAXED, __HIP_MEMORY_SCOPE_AGENT); }
__device__ __forceinline__ unsigned xb_add(unsigned* p, unsigned v) { return __hip_atomic_fetch_add(p, v, __ATOMIC_RELAXED, __HIP_MEMORY_SCOPE_AGENT); }
__device__ __forceinline__ unsigned xb_xcc_id() { return (unsigned)__builtin_amdgcn_s_getreg((3 << 11) | 20) & 0xFu; }
#define XB_SPIN(cond, bar) do { unsigned _sp = 0; while (cond) { __builtin_amdgcn_s_sleep(1); \
    if ((++_sp & 255u) == 0u) { if (xb_ld(&(bar)[XB_TMO])) break; if (_sp > XB_SPIN_CAP) { atomicAdd(&(bar)[XB_TMO], 1u); break; } } } } while (0)

struct XcdBarrier {
    unsigned* bar; unsigned x;
    volatile LAS unsigned* st;
};

__device__ __forceinline__ XcdBarrier xcd_barrier_post(unsigned* bar, volatile LAS unsigned* st) {
    XcdBarrier b; b.bar = bar; b.x = xb_xcc_id(); b.st = st;
    if (threadIdx.x == 0) (void)xb_add(&bar[XB_XCNT(b.x)], 1u);
    return b;
}
__device__ __forceinline__ void xcd_barrier_complete(unsigned* bar, unsigned x, unsigned& nloc, unsigned& nx) {
    const unsigned G = gridDim.x * gridDim.y * gridDim.z;
    unsigned sum, cnt, mine, sp = 0u;
    for (;;) {
        sum = 0u; cnt = 0u; mine = 0u;
#pragma unroll
        for (unsigned j = 0; j < 16; ++j) { const unsigned c = xb_ld(&bar[XB_XCNT(j)]); sum += c; cnt += (c > 0u) ? 1u : 0u; mine = (j == x) ? c : mine; }
        if (sum == G) break;
        __builtin_amdgcn_s_sleep(1);
        if ((++sp & 255u) == 0u) { if (xb_ld(&bar[XB_TMO])) break; if (sp > XB_SPIN_CAP) { atomicAdd(&bar[XB_TMO], 1u); break; } }
    }
    nloc = mine > 0u ? mine : 1u; nx = cnt > 0u ? cnt : 1u;
}

__device__ __forceinline__ void xcd_barrier(const XcdBarrier& b) {
    asm volatile("s_waitcnt vmcnt(0)" ::: "memory");
    __syncthreads();
    if (threadIdx.x == 0) {
        unsigned* bar = b.bar;
        __builtin_amdgcn_s_waitcnt(0);
        unsigned nloc = b.st[0], nx = b.st[1];
        if (nloc == 0u) { xcd_barrier_complete(bar, b.x, nloc, nx); b.st[0] = nloc; b.st[1] = nx; }
        const unsigned old = xb_add(&bar[XB_XSUB(b.x)], 1u);
        const unsigned gen = old / nloc;
        if (old + 1u == (gen + 1u) * nloc) {
            __builtin_amdgcn_fence(__ATOMIC_RELEASE, "agent");
            asm volatile("s_waitcnt vmcnt(0)" ::: "memory");
            const unsigned og = xb_add(&bar[XB_TOP], 1u);
            const unsigned tg = og / nx;
            if (og + 1u == (tg + 1u) * nx) xb_add(&bar[XB_TOPGEN], 1u);
            else XB_SPIN(xb_ld(&bar[XB_TOPGEN]) == tg, bar);
            __builtin_amdgcn_fence(__ATOMIC_ACQUIRE, "agent");
            xb_add(&bar[XB_XGEN(b.x)], 1u);
            asm volatile("s_waitcnt vmcnt(0)" ::: "memory");
        } else {
            XB_SPIN(xb_ld(&bar[XB_XGEN(b.x)]) == gen, bar);
            __builtin_amdgcn_fence(__ATOMIC_ACQUIRE, "agent");
            asm volatile("s_waitcnt vmcnt(0)" ::: "memory");
        }
    }
    __syncthreads();
}

constexpr int NPHASE = 12;
__global__ void __launch_bounds__(NTHREADS, 2) fwd_kernel(Args a) {
    extern __shared__ __attribute__((aligned(16))) unsigned char smem[];
    cg::grid_group grid = cg::this_grid();
    Ctx C;
#pragma unroll
    for (int i = 0; i < 30; ++i) C.in[i] = a.in[i];
    C.out = a.out; C.ws = a.ws; C.lds = (LAS uchar*)smem; C.tid = threadIdx.x; C.lane = C.tid & 63; C.wave = __builtin_amdgcn_readfirstlane(C.tid >> 6); C.G = gridDim.x; C.bid = blockIdx.x;
    const int lo = a.ph_lo, hi = a.ph_hi;
    volatile LAS unsigned* bst = (volatile LAS unsigned*)(C.lds + 131072);
    if (C.tid < 16) bst[C.tid] = 0u;
    __syncthreads();
    XcdBarrier bar; bar.bar = (unsigned*)(C.ws + OFF_CTL); bar.x = 0; bar.st = bst;
    if (hi - lo > 1) bar = xcd_barrier_post((unsigned*)(C.ws + OFF_CTL), bst);
    if (hi > NPHASE) grid.sync();
#define IN(k) (lo <= (k) && (k) < hi)
#define SEAM(k) do { if (IN(k) && IN((k) + 1)) xcd_barrier(bar); } while (0)
    if (IN(0)) { phase0(C); if (DUP == 1) { __syncthreads(); phase0(C); } }
    if (DUP == 100) { for (int q_ = 0; q_ < 10; ++q_) xcd_barrier(bar); }
    SEAM(0);
    if (IN(1)) { phase1(C); if (DUP == 2) { __syncthreads(); phase1(C); } }
    SEAM(1);
    if (IN(2)) {
        pg8::Gemm g{WSP(bf16_t, OFF_H1), WSP(bf16_t, OFF_WIN), MT, NIN, 1024}; pg8::StaticOrder S; S.init(MT, NIN, C.G, C.bid);
        EpiIn E{WSP(bf16_t, OFF_ZS), WSP(bf16_t, OFF_XBC), (bf16_t*)(C.out + 4194304), WSP(bf16_t, OFF_V), WSP(bf16_t, OFF_G), WSP(float, OFF_DT), WSP(float, OFF_VSTAT), C.in[11], C.in[12]};
        pg8::gemm_phase<EpiIn, pg8::StaticOrder, false>(C.lds, g, S, E, nullptr);
        if (DUP == 3) { __syncthreads(); pg8::gemm_phase<EpiIn, pg8::StaticOrder, false>(C.lds, g, S, E, nullptr); }
    }
    SEAM(2);
    const int vcu = (C.G % 8 == 0) ? (C.bid % 8) * (C.G / 8) + C.bid / 8 : C.bid;
    if (IN(3)) { for (int it = vcu; it < 1536; it += C.G) ssd_states_item(C, it); sgu_stats(C); }
    if (DUP == 4 && IN(3)) { for (int it = C.bid; it < 1536; it += C.G) ssd_states_item(C, it); }
    SEAM(3);
    if (IN(4)) { for (int it = C.bid; it < 2304; it += C.G) scan_item(C, it); if (C.G % 8 == 0) { for (int ck = C.bid / 8; ck < NCHUNK; ck += C.G / 8) sgu_item(C, ck * 8 + (C.bid % 8)); } else { for (int it = C.bid; it < 768; it += C.G) sgu_item(C, it); } }
    SEAM(4);
    if (IN(5)) { for (int it = vcu; it < 1536; it += C.G) ssd_out_item(C, it); }
    SEAM(5);
    if (IN(6)) {
        { pg8::Gemm g{WSP(bf16_t, OFF_ZS), WSP(bf16_t, OFF_WPA), MT, 1024, 1024}; pg8::StaticOrder S; S.init(MT, 1024, C.G, C.bid);
          EpiPA E{WSP(float, OFF_ST), WSP(bf16_t, OFF_G), WSP(float, OFF_SSQ)};
          pg8::gemm_phase<EpiPA, pg8::StaticOrder, false>(C.lds, g, S, E, nullptr);
          if (DUP == 7) { __syncthreads(); pg8::gemm_phase<EpiPA, pg8::StaticOrder, false>(C.lds, g, S, E, nullptr); } }
        __syncthreads();
        { pg8::Gemm g{(const bf16_t*)(C.out + 4194304), WSP(bf16_t, OFF_WPB), MT, 1024, 1024}; pg8::StaticOrder S; S.init(MT, 1024, C.G, C.bid);
          EpiPB E{WSP(float, OFF_ST), WSP(bf16_t, OFF_G), WSP(bf16_t, OFF_H1)};
          pg8::gemm_phase<EpiPB, pg8::StaticOrder, false>(C.lds, g, S, E, nullptr); }
    }
    SEAM(6);
    if (IN(7)) {
        pg8::Gemm g{WSP(bf16_t, OFF_H1), WSP(bf16_t, OFF_WOUT), MT, 1024, 1024}; pg8::StaticOrder S; S.init(MT, 1024, C.G, C.bid);
        EpiRes E{WSP(float, OFF_XBC), C.in[0], C.in[1], WSP(float, OFF_POS), WSP(float, OFF_MOD) + 2048, 1};
        pg8::gemm_phase<EpiRes, pg8::StaticOrder, false>(C.lds, g, S, E, nullptr);
    }
    SEAM(7);
    if (IN(8)) ln1_pass(C);
    SEAM(8);
    if (IN(9)) {
        pg8::Gemm g{WSP(bf16_t, OFF_ZS), WSP(bf16_t, OFF_WFF1), MT, DFF, 1024}; pg8::StaticOrder S; S.init(MT, DFF, C.G, C.bid);
        EpiFF1 E{WSP(bf16_t, OFF_G)};
        pg8::gemm_phase<EpiFF1, pg8::StaticOrder, false>(C.lds, g, S, E, nullptr);
        if (DUP == 10) { __syncthreads(); pg8::gemm_phase<EpiFF1, pg8::StaticOrder, false>(C.lds, g, S, E, nullptr); }
    }
    SEAM(9);
    if (IN(10)) {
        pg8::Gemm g{WSP(bf16_t, OFF_G), WSP(bf16_t, OFF_WFF2), MT, 1024, DFF}; pg8::StaticOrder S; S.init(MT, 1024, C.G, C.bid);
        EpiRes E{C.out, WSP(float, OFF_XBC), nullptr, nullptr, WSP(float, OFF_MOD) + 5120, 0};
        pg8::gemm_phase<EpiRes, pg8::StaticOrder, false>(C.lds, g, S, E, nullptr);
        if (DUP == 11) { __syncthreads(); pg8::gemm_phase<EpiRes, pg8::StaticOrder, false>(C.lds, g, S, E, nullptr); }
    }
    SEAM(10);
    if (IN(11)) ln2_pass(C);
#undef IN
#undef SEAM
}

extern "C" void kernel_launch(void* const* d_in, const int* in_sizes, int n_in, void* d_out, int out_size, void* d_ws, size_t ws_size, hipStream_t stream) {
    static int grid = 0;
    if (grid == 0) {
        if (n_in != 30 || out_size != 16777216 || ws_size < WS_END) { fprintf(stderr, "kernel_launch: unexpected shapes (n_in %d out %d ws %zu)\n", n_in, out_size, ws_size); grid = -1; return; }
        int dev = 0, cus = 0, per_cu = 0;
        (void)hipGetDevice(&dev); (void)hipDeviceGetAttribute(&cus, hipDeviceAttributeMultiprocessorCount, dev);
        if (hipFuncSetAttribute((const void*)fwd_kernel, hipFuncAttributeMaxDynamicSharedMemorySize, LDS_BYTES) != hipSuccess) { fprintf(stderr, "hipFuncSetAttribute failed\n"); grid = -1; return; }
        if (hipOccupancyMaxActiveBlocksPerMultiprocessor(&per_cu, (const void*)fwd_kernel, NTHREADS, LDS_BYTES) != hipSuccess || per_cu < 1) per_cu = 1;
        (void)hipGetLastError();
        grid = cus > 0 ? cus : 256;
    }
    if (grid < 0) return;
    Args a{};
    for (int i = 0; i < 30; ++i) a.in[i] = (const float*)d_in[i];
    a.out = (float*)d_out; a.ws = (unsigned char*)d_ws;
    if (hipMemsetAsync((char*)d_ws + OFF_CTL, 0, 16384, stream) != hipSuccess) { fprintf(stderr, "memset failed\n"); return; }
#if MULTI_LAUNCH
    for (int ph = 0; ph < NPHASE; ++ph) { a.ph_lo = ph; a.ph_hi = ph + 1; hipLaunchKernelGGL(fwd_kernel, dim3(grid), dim3(NTHREADS), LDS_BYTES, stream, a); }
#else
    a.ph_lo = 0; a.ph_hi = NPHASE;
    void* args[] = {&a};
    hipError_t e = hipLaunchCooperativeKernel((const void*)fwd_kernel, dim3(grid), dim3(NTHREADS), args, LDS_BYTES, stream);
    if (e != hipSuccess) fprintf(stderr, "cooperative launch failed: %s (grid %d)\n", hipGetErrorString(e), grid);
#endif
}
```

```cpp
#include <hip/hip_runtime.h>
#include <hip/hip_cooperative_groups.h>
#include <cstdio>
namespace cg = cooperative_groups;
#ifndef DUP
#define DUP 0
#endif
#ifndef MULTI_LAUNCH
#define MULTI_LAUNCH 0
#endif
namespace pg8 {
#define PG8_LAS __attribute__((address_space(3)))
typedef unsigned short bf16_t;
typedef short bf16x8 __attribute__((ext_vector_type(8)));
typedef float f32x4 __attribute__((ext_vector_type(4)));
typedef unsigned u32x4 __attribute__((ext_vector_type(4)));
constexpr int BM = 256, BK = 64, HALF = 128, HTB = HALF * BK * 2  , STAGE_BYTES = 8 * HTB, NXCD = 8, WGM = 8;

__host__ __device__ __forceinline__ int lds_byte(int r, int c) { const int st = (r >> 4) * 2 + (c >> 5), rr = r & 15, cc = c & 31, ob = rr * 64 + cc * 2; return st * 1024 + (ob ^ (((ob >> 9) & 1) << 5)); }
__host__ __device__ __forceinline__ void stage_rc(int b, int& R, int& C) { const int st = b / 1024, sb = b % 1024, swz = sb ^ (((sb >> 9) & 1) << 5); R = (st >> 1) * 16 + swz / 64; C = (st & 1) * 32 + (swz % 64) / 2; }
__host__ __device__ __forceinline__ int perm32(int rho) { const int n = rho >> 4, i = rho & 15; return 8 * (i >> 2) + 4 * n + (i & 3); }

struct Unit { int pm, pn, kh; };
struct Gemm { const bf16_t* A; const bf16_t* Bt; int M, N, K, ld; };

struct StaticOrder {
    int nM, nN, nwg, G, c;
    __host__ __device__ void init(int M, int N, int G_, int c_) { nM = M / BM; nN = N / BM; nwg = nM * nN; G = G_; c = c_; }
    __host__ __device__ __forceinline__ bool next(int i, Unit& u) const {
        const long L = (long)i * G + c; if (L >= nwg) return false;
        int wgid = (int)L; { const int q = nwg / NXCD, r = nwg % NXCD, xcd = wgid % NXCD, off = wgid / NXCD; wgid = (xcd < r ? xcd * (q + 1) : r * (q + 1) + (xcd - r) * q) + off; }
        const int nig = WGM * nN, gid = wgid / nig, fm = gid * WGM, gsz = (nM - fm) < WGM ? (nM - fm) : WGM;
        u.pm = fm + ((wgid % nig) % gsz); u.pn = (wgid % nig) / gsz; u.kh = 0; return true;
    }
    __device__ __forceinline__ void a_ready(const Unit&) const {}
    __device__ __forceinline__ void done(const Unit&) const {}
};
struct ChainOrder : StaticOrder {
    __host__ __device__ __forceinline__ bool next(int i, Unit& u) const { if (!StaticOrder::next(i >> 1, u)) return false; u.kh = i & 1; return true; }
};
typedef float f32x2 __attribute__((ext_vector_type(2)));
__device__ __forceinline__ f32x2 gelu_pk(f32x2 v) {
    const f32x2 av = __builtin_elementwise_abs(v), d = av * 0.2316418882f + 1.0f;
    f32x2 t; t.x = __builtin_amdgcn_rcpf(d.x); t.y = __builtin_amdgcn_rcpf(d.y);
    f32x2 q = t * 0.5307027145f + (-0.7265760135f); q = q * t + 0.7107068705f; q = q * t + (-0.142248368f); q = q * t + 0.127414796f; q = q * t;
    const f32x2 s = (v * v) * (-0.72134752044f);
    f32x2 e; e.x = __builtin_amdgcn_exp2f(s.x); e.y = __builtin_amdgcn_exp2f(s.y);
    const f32x2 m = v * (q * e), r = v - m;
    f32x2 o; o.x = v.x < 0.f ? m.x : r.x; o.y = v.y < 0.f ? m.y : r.y; return o;
}
template <class Epi, class Sched, bool STAMP = false>
__device__ __forceinline__ void gemm_phase(PG8_LAS unsigned char* lds, const Gemm g, const Sched& S, const Epi& E, unsigned long long* stamps) {
    const int tid = threadIdx.x, wid = __builtin_amdgcn_readfirstlane(tid >> 6), lane = tid & 63, wr = wid >> 2, wc = wid & 3, fr = lane & 15, fq = lane >> 4;
    const int K = g.K, nt = K / BK;
    int ts_lo = 0, ts_hi = 0, nts = 0; const unsigned long long rt_entry = STAMP ? (unsigned long long)wall_clock64() : 0ull;
#define PG8_STAMP() do { if (STAMP && wid == 0 && nts < 64) { const unsigned long long _c = (unsigned long long)clock64(); \
        ts_lo = (lane == nts) ? (int)(unsigned)_c : ts_lo; ts_hi = (lane == nts) ? (int)(unsigned)(_c >> 32) : ts_hi; ++nts; } } while (0)
    PG8_STAMP();
    unsigned voffA[2], voffB[2];
#pragma unroll
    for (int i = 0; i < 2; ++i) { int R, C; stage_rc(tid * 16 + i * 8192, R, C); const int Rb = Epi::PERM ? ((R & ~31) + perm32(R & 31)) : R;
        voffA[i] = (unsigned)(R * g.ld + C) * 2u; voffB[i] = (unsigned)(Rb * g.ld + C) * 2u; }
    const size_t kstep = (size_t)(BK * 2);
    const size_t hstep = (size_t)HALF * g.ld * 2;
    const size_t tstep = 2 * hstep;
    const unsigned ldsw = (unsigned)wid * 1024u;
    const int aoff = lds_byte(wr * 64 + fr, fq * 8), boff = lds_byte(wc * 32 + fr, fq * 8);
#define PG8_SA(b, h) (((b) * 2 + (h)) * HTB)
#define PG8_SB(b, h) ((4 + (b) * 2 + (h)) * HTB)
#define PG8_STAGE(bufoff, gbase, voff) do { _Pragma("unroll") for (int _i = 0; _i < 2; ++_i) \
        __builtin_amdgcn_global_load_lds((const unsigned*)((const char*)(gbase) + (voff)[_i]), (PG8_LAS unsigned*)(lds + (bufoff) + ldsw + _i * 8192), 16, 0, 0); } while (0)
#define PG8_LDA(dst, b, h) do { _Pragma("unroll") for (int m = 0; m < 4; ++m) _Pragma("unroll") for (int k = 0; k < 2; ++k) dst[m][k] = *(const PG8_LAS bf16x8*)(lds + PG8_SA(b, h) + aoff + m * 2048 + k * 1024); } while (0)
#define PG8_LDB(dst, b, h) do { _Pragma("unroll") for (int n = 0; n < 2; ++n) _Pragma("unroll") for (int k = 0; k < 2; ++k) dst[n][k] = *(const PG8_LAS bf16x8*)(lds + PG8_SB(b, h) + boff + n * 2048 + k * 1024); } while (0)
#define PG8_MMA(ai, bj, At, Bt) do { __builtin_amdgcn_s_setprio(1); _Pragma("unroll") for (int m = 0; m < 4; ++m) _Pragma("unroll") for (int n = 0; n < 2; ++n) _Pragma("unroll") for (int k = 0; k < 2; ++k) \
        acc[ai][bj][m][n] = __builtin_amdgcn_mfma_f32_16x16x32_bf16(Bt[n][k], At[m][k], acc[ai][bj][m][n], 0, 0, 0); __builtin_amdgcn_s_setprio(0); } while (0)
#define PG8_WAIT_V(n) asm volatile("s_waitcnt vmcnt(" #n ")" ::: "memory")
#define PG8_WAIT_L(n) asm volatile("s_waitcnt lgkmcnt(" #n ")" ::: "memory")
#define PG8_BAR __builtin_amdgcn_s_barrier()
#define PG8_SCHED __builtin_amdgcn_sched_barrier(0)
    Unit cur, nxt; int ui = 0;
    if (!S.next(0, cur)) return;
    f32x4 acc[2][2][4][2];
#pragma unroll
    for (int a = 0; a < 2; ++a)
#pragma unroll
        for (int b = 0; b < 2; ++b)
#pragma unroll
            for (int m = 0; m < 4; ++m)
#pragma unroll
                for (int n = 0; n < 2; ++n) acc[a][b][m][n] = (f32x4){0.f, 0.f, 0.f, 0.f};
    bf16x8 At[4][2], B0[2][2], B1[2][2];
    const char* cA = (const char*)g.A + (size_t)cur.pm * tstep + (size_t)cur.kh * K * 2; const char* cB = (const char*)g.Bt + (size_t)cur.pn * tstep + (size_t)cur.kh * K * 2;
    S.a_ready(cur);
    PG8_STAGE(PG8_SB(0, 0), cB, voffB); PG8_STAGE(PG8_SA(0, 0), cA, voffA); PG8_STAGE(PG8_SB(0, 1), cB + hstep, voffB); PG8_STAGE(PG8_SA(0, 1), cA + hstep, voffA);
    if (wr == 1) PG8_BAR;
    PG8_WAIT_V(4); PG8_BAR;
    PG8_STAGE(PG8_SB(1, 0), cB + kstep, voffB); PG8_STAGE(PG8_SA(1, 0), cA + kstep, voffA); PG8_STAGE(PG8_SB(1, 1), cB + hstep + kstep, voffB);
    PG8_WAIT_V(6); PG8_BAR;
    PG8_STAMP();
    for (;;) {
        const bool has_next = S.next(ui + 1, nxt);
        const char* nA = has_next ? (const char*)g.A + (size_t)nxt.pm * tstep + (size_t)nxt.kh * K * 2 : cA; const char* nB = has_next ? (const char*)g.Bt + (size_t)nxt.pn * tstep + (size_t)nxt.kh * K * 2 : cB;
        for (int t = 0; t < nt; t += 2) {
            const bool last = (t == nt - 2);
            const char* a1 = cA + (size_t)(t + 1) * kstep;
            const char* a2 = last ? nA : cA + (size_t)(t + 2) * kstep; const char* b2 = last ? nB : cB + (size_t)(t + 2) * kstep;
            const char* a3 = a2 + kstep; const char* b3 = b2 + kstep;
            if (last && has_next) S.a_ready(nxt);
            PG8_LDB(B0, 0, 0); PG8_SCHED; PG8_LDA(At, 0, 0); PG8_STAGE(PG8_SA(1, 1), a1 + hstep, voffA);
            PG8_WAIT_L(8); PG8_BAR; PG8_WAIT_L(0); PG8_MMA(0, 0, At, B0); PG8_BAR; PG8_SCHED;
            PG8_LDB(B1, 0, 1); PG8_STAGE(PG8_SB(0, 0), b2, voffB);
            PG8_BAR; PG8_WAIT_L(0); PG8_MMA(0, 1, At, B1); PG8_BAR;
            PG8_LDA(At, 0, 1); PG8_STAGE(PG8_SA(0, 0), a2, voffA);
            PG8_BAR; PG8_WAIT_L(0); PG8_MMA(1, 0, At, B0); PG8_BAR; PG8_SCHED;
            PG8_STAGE(PG8_SB(0, 1), b2 + hstep, voffB);
            PG8_WAIT_V(6); PG8_BAR; PG8_MMA(1, 1, At, B1); PG8_BAR;
            PG8_LDB(B0, 1, 0); PG8_SCHED; PG8_LDA(At, 1, 0); PG8_STAGE(PG8_SA(0, 1), a2 + hstep, voffA);
            PG8_WAIT_L(8); PG8_BAR; PG8_WAIT_L(0); PG8_MMA(0, 0, At, B0); PG8_BAR; PG8_SCHED;
            PG8_LDB(B1, 1, 1); PG8_STAGE(PG8_SB(1, 0), b3, voffB);
            PG8_BAR; PG8_WAIT_L(0); PG8_MMA(0, 1, At, B1); PG8_BAR;
            PG8_LDA(At, 1, 1); PG8_STAGE(PG8_SA(1, 0), a3, voffA);
            PG8_BAR; PG8_WAIT_L(0); PG8_MMA(1, 0, At, B0); PG8_BAR; PG8_SCHED;
            PG8_STAGE(PG8_SB(1, 1), b3 + hstep, voffB);
            PG8_WAIT_V(6); PG8_BAR; PG8_MMA(1, 1, At, B1); PG8_BAR;
        }
        PG8_STAMP();
        if constexpr (Epi::HAS_MID) { if (cur.kh == 0) E.mid(acc, cur, ui >> 1, wr, wc, fr, fq); else E(acc, cur, wr, wc, fr, fq); }
        else if constexpr (!Epi::AFTER_DRAIN) { E(acc, cur, wr, wc, fr, fq); S.done(cur); }
        PG8_STAMP();
        if (!has_next) break;
        if (!Epi::HAS_MID || cur.kh == 1) {
#pragma unroll
        for (int a = 0; a < 2; ++a)
#pragma unroll
            for (int b = 0; b < 2; ++b)
#pragma unroll
                for (int m = 0; m < 4; ++m)
#pragma unroll
                    for (int n = 0; n < 2; ++n) acc[a][b][m][n] = (f32x4){0.f, 0.f, 0.f, 0.f};
        }
        cur = nxt; cA = nA; cB = nB; ++ui;
    }
    PG8_WAIT_V(0);
    if (wr == 0) PG8_BAR;
    PG8_BAR;
    if constexpr (Epi::AFTER_DRAIN) { E.fused(acc, cur, wr, wc, fr, fq, lds, wid, lane); S.done(cur); }
    PG8_STAMP();
    if (STAMP && wid == 0) { stamps[lane] = lane < nts ? (((unsigned long long)(unsigned)ts_hi << 32) | (unsigned)ts_lo) : 0ull;
        if (lane == 62) stamps[62] = rt_entry; if (lane == 63) stamps[63] = (unsigned long long)wall_clock64(); }
#undef PG8_STAMP
#undef PG8_SA
#undef PG8_SB
#undef PG8_STAGE
#undef PG8_LDA
#undef PG8_LDB
#undef PG8_MMA
#undef PG8_WAIT_V
#undef PG8_WAIT_L
#undef PG8_BAR
#undef PG8_SCHED
}
}

#define LAS __attribute__((address_space(3)))
typedef unsigned short bf16_t;
typedef unsigned char uchar;
typedef short bf16x8 __attribute__((ext_vector_type(8)));
typedef float f32x4 __attribute__((ext_vector_type(4)));
typedef float f32x2 __attribute__((ext_vector_type(2)));
typedef float f32x16 __attribute__((ext_vector_type(16)));
typedef unsigned u32x4 __attribute__((ext_vector_type(4)));
typedef unsigned u32x2 __attribute__((ext_vector_type(2)));

constexpr int MT = 12288, DM = 1024, NCTX_TOK = 4096, NCHUNK = 96, NIN = 6656, NIN_ROWS = 6912, DFF = 4096;
constexpr float DN_ALPHA = 1.189207115002721f;
constexpr float EPS = 1e-5f;
constexpr int LDS_BYTES = 131072 + 64 + 4096;
constexpr int NTHREADS = 512;

constexpr size_t OFF_WIN = 0;
constexpr size_t OFF_WPA = OFF_WIN + (size_t)NIN_ROWS * 1024 * 2;
constexpr size_t OFF_WPB = OFF_WPA + 2097152;
constexpr size_t OFF_WOUT = OFF_WPB + 2097152;
constexpr size_t OFF_WFF1 = OFF_WOUT + 2097152;
constexpr size_t OFF_WFF2 = OFF_WFF1 + 8388608;
constexpr size_t OFF_WSP = OFF_WFF2 + 8388608;
constexpr size_t OFF_MODP = OFF_WSP + 262144;
constexpr size_t OFF_MOD = OFF_MODP + 16 * 3 * 6144 * 4;
constexpr size_t OFF_POS = OFF_MOD + 3 * 6144 * 4;
constexpr size_t OFF_DT = OFF_POS + 64 * 512 * 4;
constexpr size_t OFF_VSTAT = OFF_DT + (size_t)MT * 32 * 4;
constexpr size_t OFF_SSQ = OFF_VSTAT + (size_t)MT * 16 * 2 * 4;
constexpr size_t OFF_AL = OFF_SSQ + (size_t)MT * 32 * 4;
constexpr size_t OFF_H1 = OFF_AL + 96 * 16 * 2 * 4;
constexpr size_t OFF_ZS = OFF_H1 + (size_t)MT * 1024 * 2;
constexpr size_t OFF_XBC = OFF_ZS + (size_t)MT * 1024 * 2;
constexpr size_t OFF_V = OFF_XBC + (size_t)MT * 1536 * 2;
constexpr size_t OFF_G = OFF_V + (size_t)MT * 1024 * 2;
constexpr size_t OFF_ST = OFF_G + (size_t)MT * 2048 * 2;
constexpr size_t OFF_CTL = OFF_ST + (size_t)MT * 1024 * 4;
constexpr size_t WS_END = OFF_CTL + 16384;
static_assert(WS_END <= 268435456ull, "workspace");
static_assert((size_t)MT * 1024 * 4 <= (size_t)MT * 1536 * 2 + (size_t)MT * 1024 * 2, "R1 fits in XBC+V");

struct Args {
    const float* in[30];
    float* out;
    unsigned char* ws;
    int ph_lo, ph_hi;
};

typedef __bf16 bf16x2_t __attribute__((ext_vector_type(2)));
__device__ __forceinline__ unsigned pk_bf16(float lo, float hi) { bf16x2_t v = {(__bf16)lo, (__bf16)hi}; return __builtin_bit_cast(unsigned, v); }
__device__ __forceinline__ float bf_lo(unsigned u) { return __uint_as_float(u << 16); }
__device__ __forceinline__ float bf_hi(unsigned u) { return __uint_as_float(u & 0xffff0000u); }
__device__ __forceinline__ float bf1(bf16_t b) { return __uint_as_float(((unsigned)b) << 16); }
__device__ __forceinline__ bf16_t to_bf1(float f) { return (bf16_t)(pk_bf16(f, 0.f) & 0xffffu); }
__device__ __forceinline__ float fast_rcp(float x) { return __builtin_amdgcn_rcpf(x); }
__device__ __forceinline__ float sigmoidf_(float v) { return fast_rcp(1.0f + __expf(-v)); }
__device__ __forceinline__ float siluf_(float v) { return v * sigmoidf_(v); }
__device__ __forceinline__ float softplusf_(float v) { return v > 20.f ? v : log1pf(__expf(v)); }
__device__ __forceinline__ float wave_sum(float v) {
#pragma unroll
    for (int o = 1; o < 64; o <<= 1) v += __shfl_xor(v, o);
    return v;
}
__device__ __forceinline__ void unpack8(u32x4 v, float (&o)[8]) {
    o[0] = bf_lo(v.x); o[1] = bf_hi(v.x); o[2] = bf_lo(v.y); o[3] = bf_hi(v.y); o[4] = bf_lo(v.z); o[5] = bf_hi(v.z); o[6] = bf_lo(v.w); o[7] = bf_hi(v.w);
}
__device__ __forceinline__ int mod_idx(int t) { return t < NCTX_TOK ? 0 : 1 + ((t - NCTX_TOK) >> 12); }
__device__ __forceinline__ void seq_bounds(int chunk, int& t0, int& t1) {
    if (chunk < 32) { t0 = (chunk >> 1) * 256; t1 = t0 + 256; } else { t0 = NCTX_TOK + ((chunk - 32) >> 5) * 4096; t1 = t0 + 4096; }
}

using pg8::Unit;
struct EpiIn {
    static constexpr bool PERM = true, AFTER_DRAIN = false, HAS_MID = false;
    bf16_t *ZS, *XBC, *U, *V, *G; float* DT; float* VSTAT; const float *dtbf, *dtbb;
    __device__ __forceinline__ void operator()(const f32x4 (&acc)[2][2][4][2], const Unit& u, int wr, int wc, int fr, int fq) const {
        const int pn = u.pn; const int row0 = u.pm * 256 + wr * 64 + fr;
        bf16_t* dst; int ld, cb, act;
        if (pn < 4) { dst = ZS; ld = 2048; cb = pn * 256; act = 1; }
        else if (pn < 10) { dst = XBC; ld = 1536; cb = (pn - 4) * 256; act = 0; }
        else if (pn < 14) { dst = U; ld = 2048; cb = (pn - 10) * 256; act = 2; }
        else if (pn < 18) { dst = V; ld = 1024; cb = (pn - 14) * 256; act = 3; }
        else { dst = G; ld = 2048; cb = (pn - 18) * 256; act = 4; }
        const int col0 = cb + wc * 32 + 8 * fq;
#pragma unroll
        for (int ai = 0; ai < 2; ++ai)
#pragma unroll
            for (int m = 0; m < 4; ++m) {
                const int r = row0 + ai * 128 + m * 16; bf16_t* rowp = dst + (size_t)r * ld + col0;
                float s = 0.f, ss = 0.f;
#pragma unroll
                for (int bj = 0; bj < 2; ++bj) {
                    f32x4 v0 = acc[ai][bj][m][0], v1 = acc[ai][bj][m][1];
                    if (act == 1) {
#pragma unroll
                        for (int j = 0; j < 4; ++j) { v0[j] = siluf_(v0[j]); v1[j] = siluf_(v1[j]); }
                    } else if (act == 2 || act == 3) {
                        f32x2 a = pg8::gelu_pk((f32x2){v0[0], v0[1]}), b = pg8::gelu_pk((f32x2){v0[2], v0[3]}), c = pg8::gelu_pk((f32x2){v1[0], v1[1]}), d = pg8::gelu_pk((f32x2){v1[2], v1[3]});
                        v0 = (f32x4){a.x, a.y, b.x, b.y}; v1 = (f32x4){c.x, c.y, d.x, d.y};
                        if (act == 3) {
#pragma unroll
                            for (int j = 0; j < 4; ++j) { s += v0[j] + v1[j]; ss += v0[j] * v0[j] + v1[j] * v1[j]; }
                        }
                    } else if (act == 4) {
#pragma unroll
                        for (int j = 0; j < 4; ++j) { v0[j] = sigmoidf_(v0[j]); v1[j] = sigmoidf_(v1[j]); }
                    }
                    u32x4 w; w.x = pk_bf16(v0[0], v0[1]); w.y = pk_bf16(v0[2], v0[3]); w.z = pk_bf16(v1[0], v1[1]); w.w = pk_bf16(v1[2], v1[3]);
                    *(u32x4*)(rowp + bj * 128) = w;
                }
                if (act == 3) {
                    s += __shfl_xor(s, 16); s += __shfl_xor(s, 32); ss += __shfl_xor(ss, 16); ss += __shfl_xor(ss, 32);
                    if (fq == 0) *(f32x2*)(VSTAT + ((size_t)r * 16 + (pn - 14) * 4 + wc) * 2) = (f32x2){s, ss};
                }
            }
    }
};
struct EpiPAB {
    static constexpr bool PERM = false, AFTER_DRAIN = false, HAS_MID = true;
    const bf16_t* G; const LAS float* RS; bf16_t* MB;
    __device__ __forceinline__ void mid(f32x4 (&acc)[2][2][4][2], const Unit& u, int ui, int wr, int wc, int fr, int fq) const {
        const int row0 = u.pm * 256 + wr * 64 + fr, col0 = u.pn * 256 + wc * 32 + 4 * fq;
        const LAS float* rs = RS + (ui & 3) * 256 + wr * 64 + fr;
#pragma unroll
        for (int ai = 0; ai < 2; ++ai)
#pragma unroll
            for (int m = 0; m < 4; ++m) {
                const int r = row0 + ai * 128 + m * 16;
                const float rstd = rs[ai * 128 + m * 16];
                const bf16_t* gp = G + (size_t)r * 2048 + col0;
#pragma unroll
                for (int bj = 0; bj < 2; ++bj)
#pragma unroll
                    for (int n = 0; n < 2; ++n) {
                        const u32x2 ga = *(const u32x2*)(gp + bj * 128 + n * 16), gb = *(const u32x2*)(gp + 1024 + bj * 128 + n * 16);
                        f32x4 o = acc[ai][bj][m][n] * rstd;
                        o[0] *= bf_lo(ga.x) * fast_rcp(fmaxf(bf_lo(gb.x), 1e-6f)); o[1] *= bf_hi(ga.x) * fast_rcp(fmaxf(bf_hi(gb.x), 1e-6f));
                        o[2] *= bf_lo(ga.y) * fast_rcp(fmaxf(bf_lo(gb.y), 1e-6f)); o[3] *= bf_hi(ga.y) * fast_rcp(fmaxf(bf_hi(gb.y), 1e-6f));
                        acc[ai][bj][m][n] = o;
                    }
                asm volatile("" ::: "memory");
            }
    }
    __device__ __forceinline__ void operator()(const f32x4 (&acc)[2][2][4][2], const Unit& u, int wr, int wc, int fr, int fq) const {
        const int row0 = u.pm * 256 + wr * 64 + fr, col0 = u.pn * 256 + wc * 32 + 4 * fq;
#pragma unroll
        for (int ai = 0; ai < 2; ++ai)
#pragma unroll
            for (int m = 0; m < 4; ++m) {
                const int r = row0 + ai * 128 + m * 16;
#pragma unroll
                for (int bj = 0; bj < 2; ++bj)
#pragma unroll
                    for (int n = 0; n < 2; ++n) {
                        const int c = col0 + bj * 128 + n * 16;
                        const u32x2 gb = *(const u32x2*)(G + (size_t)r * 2048 + 1024 + c); const f32x4 a = acc[ai][bj][m][n];
                        u32x2 w; w.x = pk_bf16(a[0] * fmaxf(bf_lo(gb.x), 1e-6f), a[1] * fmaxf(bf_hi(gb.x), 1e-6f)); w.y = pk_bf16(a[2] * fmaxf(bf_lo(gb.y), 1e-6f), a[3] * fmaxf(bf_hi(gb.y), 1e-6f));
                        *(u32x2*)(MB + (size_t)r * 1024 + c) = w;
                    }
            }
    }
};
struct EpiRes {
    static constexpr bool PERM = false, AFTER_DRAIN = false, HAS_MID = false;
    float* dst; const float* base; const float* xs; const float* POS; const float* gate; int posx;
    __device__ __forceinline__ void operator()(const f32x4 (&acc)[2][2][4][2], const Unit& u, int wr, int wc, int fr, int fq) const {
        const int row0 = u.pm * 256 + wr * 64 + fr, col0 = u.pn * 256 + wc * 32 + 4 * fq;
        const int mi = mod_idx(u.pm * 256); const bool lat = posx && (u.pm * 256 >= NCTX_TOK);
        f32x4 gt[2][2];
#pragma unroll
        for (int bj = 0; bj < 2; ++bj)
#pragma unroll
            for (int n = 0; n < 2; ++n) gt[bj][n] = *(const f32x4*)(gate + (size_t)mi * 6144 + col0 + bj * 128 + n * 16);
#pragma unroll
        for (int ai = 0; ai < 2; ++ai)
#pragma unroll
            for (int m = 0; m < 4; ++m) {
                const int r = row0 + ai * 128 + m * 16;
                const float* bp = lat ? xs + (size_t)(r - NCTX_TOK) * 1024 : base + (size_t)r * 1024;
                const int tt = (r - NCTX_TOK) & 4095;
#pragma unroll
                for (int bj = 0; bj < 2; ++bj)
#pragma unroll
                    for (int n = 0; n < 2; ++n) {
                        const int c = col0 + bj * 128 + n * 16;
                        f32x4 b = *(const f32x4*)(bp + c);
                        if (lat) { const float* pp = c < 512 ? POS + (tt >> 6) * 512 + c : POS + (tt & 63) * 512 + (c - 512); b += *(const f32x4*)pp; }
                        *(f32x4*)(dst + (size_t)r * 1024 + c) = b * DN_ALPHA + gt[bj][n] * acc[ai][bj][m][n];
                    }
            }
    }
};
struct EpiFF1 {
    static constexpr bool PERM = true, AFTER_DRAIN = false, HAS_MID = false;
    bf16_t* FH;
    __device__ __forceinline__ void operator()(const f32x4 (&acc)[2][2][4][2], const Unit& u, int wr, int wc, int fr, int fq) const {
        const int row0 = u.pm * 256 + wr * 64 + fr, col0 = u.pn * 256 + wc * 32 + 8 * fq;
#pragma unroll
        for (int ai = 0; ai < 2; ++ai)
#pragma unroll
            for (int m = 0; m < 4; ++m) {
                bf16_t* rowp = FH + (size_t)(row0 + ai * 128 + m * 16) * DFF + col0;
#pragma unroll
                for (int bj = 0; bj < 2; ++bj) {
                    f32x4 v0 = acc[ai][bj][m][0], v1 = acc[ai][bj][m][1];
#pragma unroll
                    for (int j = 0; j < 4; ++j) { const float a = fmaxf(v0[j], 0.f), b = fmaxf(v1[j], 0.f); v0[j] = a * a; v1[j] = b * b; }
                    u32x4 w; w.x = pk_bf16(v0[0], v0[1]); w.y = pk_bf16(v0[2], v0[3]); w.z = pk_bf16(v1[0], v1[1]); w.w = pk_bf16(v1[2], v1[3]);
                    *(u32x4*)(rowp + bj * 128) = w;
                }
            }
    }
};

struct Ctx {
    float* out; uchar* ws; LAS uchar* lds; int tid, lane, wave, G, bid;
};
#define WSP(T, off) ((T*)(C.ws + (off)))
#define KIN(k) (((const float* const __attribute__((address_space(4)))*)__builtin_amdgcn_kernarg_segment_ptr())[k])

__device__ __forceinline__ void transpose_item(const float* W, int K, int N, bf16_t* WT, int item, int lane, LAS float* scr, bool remap_in, int ldk, int koff) {
    const int nblk = N / 32, kb = item / nblk, nb = item % nblk, k0 = 64 * kb, n0 = 32 * nb;
#pragma unroll 8
    for (int i = 0; i < 32; ++i) { const int kk = 2 * i + (lane >> 5); scr[kk * 33 + (lane & 31)] = W[(size_t)(k0 + kk) * N + n0 + (lane & 31)]; }
    asm volatile("s_waitcnt lgkmcnt(0)" ::: "memory");
    int d0 = n0;
    if (remap_in) d0 = n0 < 2560 ? n0 : (n0 < 2592 ? 6656 + (n0 - 2560) : n0 - 32);
    const int c = lane & 7;
#pragma unroll
    for (int j = 0; j < 4; ++j) { const int n = (lane >> 3) + 8 * j; const LAS float* s = scr + (8 * c) * 33 + n;
        u32x4 o; o.x = pk_bf16(s[0 * 33], s[1 * 33]); o.y = pk_bf16(s[2 * 33], s[3 * 33]); o.z = pk_bf16(s[4 * 33], s[5 * 33]); o.w = pk_bf16(s[6 * 33], s[7 * 33]);
        *(u32x4*)(WT + (size_t)(d0 + n) * ldk + koff + k0 + 8 * c) = o; }
    asm volatile("s_waitcnt lgkmcnt(0)" ::: "memory");
}
__device__ __forceinline__ void phase0(Ctx& C) {
    {
        LAS float* sv = (LAS float*)C.lds;
        bool have = false;
        for (int it = C.bid; it < 192; it += C.G) {
            if (!have) {
                for (int i = C.tid; i < 3072; i += NTHREADS) { const int m = i >> 10, k = i & 1023; const float v = m == 0 ? KIN(5)[k] : KIN(4)[(m - 1) * 1024 + k]; sv[i] = siluf_(v); }
                __syncthreads(); have = true;
            }
            const int cgp = it % 12, ks = it / 12, col = cgp * 512 + C.tid;
            const float* w = KIN(6) + (size_t)(ks * 64) * 6144 + col;
            float a0 = 0.f, a1 = 0.f, a2 = 0.f;
#pragma unroll 8
            for (int k = 0; k < 64; ++k) { const float wv = w[(size_t)k * 6144]; const int kk = ks * 64 + k; a0 += sv[kk] * wv; a1 += sv[1024 + kk] * wv; a2 += sv[2048 + kk] * wv; }
            if (ks == 0) { const float b = KIN(7)[col]; a0 += b; a1 += b; a2 += b; }
            float* mp = WSP(float, OFF_MODP) + (size_t)ks * 18432 + col;
            mp[0] = a0; mp[6144] = a1; mp[12288] = a2;
        }
        __syncthreads();
    }
    {
        LAS float* scr = (LAS float*)(C.lds + C.wave * 8448);
        const int gw = C.bid * 8 + C.wave, NGW = C.G * 8;
        constexpr int I_IN = 16 * 209, I_SQ = 16 * 32, I_F1 = 16 * 128, I_F2 = 64 * 32;
        constexpr int NIT = I_IN + 3 * I_SQ + I_F1 + I_F2;
        for (int it = gw; it < NIT; it += NGW) {
            int r = it;
            if (r < I_IN) { transpose_item(KIN(8), 1024, 6688, WSP(bf16_t, OFF_WIN), r, C.lane, scr, true, 1024, 0); continue; } r -= I_IN;
            if (r < I_SQ) { transpose_item(KIN(21), 1024, 1024, WSP(bf16_t, OFF_WPA), r, C.lane, scr, false, 2048, 0); continue; } r -= I_SQ;
            if (r < I_SQ) { transpose_item(KIN(22), 1024, 1024, WSP(bf16_t, OFF_WPA), r, C.lane, scr, false, 2048, 1024); continue; } r -= I_SQ;
            if (r < I_SQ) { transpose_item(KIN(23), 1024, 1024, WSP(bf16_t, OFF_WOUT), r, C.lane, scr, false, 1024, 0); continue; } r -= I_SQ;
            if (r < I_F1) { transpose_item(KIN(26), 1024, 4096, WSP(bf16_t, OFF_WFF1), r, C.lane, scr, false, 1024, 0); continue; } r -= I_F1;
            transpose_item(KIN(27), 4096, 1024, WSP(bf16_t, OFF_WFF2), r, C.lane, scr, false, 4096, 0);
        }
    }
    const int gt = C.bid * NTHREADS + C.tid, NGT = C.G * NTHREADS;
    { const f32x4* s = (const f32x4*)KIN(19); u32x2* d = WSP(u32x2, OFF_WSP); for (int i = gt; i < 131072 / 4; i += NGT) { const f32x4 v = s[i]; d[i] = (u32x2){pk_bf16(v[0], v[1]), pk_bf16(v[2], v[3])}; } }
    { float* P = WSP(float, OFF_POS); for (int i = gt; i < 64 * 512; i += NGT) { const int r = i >> 9, c = i & 511, q = c & 255;
        const float omega = exp2f(-(float)q * (13.287712379549449f / 256.0f)); const float ang = (float)r * omega; P[i] = c < 256 ? sinf(ang) : cosf(ang); } }
}

__device__ __forceinline__ void phase1(Ctx& C) {
    LAS float* ml = (LAS float*)C.lds;
    LAS uchar* HR = C.lds + 24576;
    constexpr int HP = 2064;
    const float* MODP = WSP(float, OFF_MODP);
    for (int i = C.tid; i < 6144; i += NTHREADS) { const int m = i >> 11, c = i & 2047; float s = 0.f;
#pragma unroll
        for (int ks = 0; ks < 16; ++ks) s += MODP[(size_t)ks * 18432 + m * 6144 + c];
        ml[i] = s; }
    if (C.bid < 36) { const int i = C.bid * 512 + C.tid; float s = 0.f;
#pragma unroll
        for (int ks = 0; ks < 16; ++ks) s += MODP[(size_t)ks * 18432 + i];
        WSP(float, OFF_MOD)[i] = s; }
    __syncthreads();
    const float* POS = WSP(float, OFF_POS); bf16_t* H1 = WSP(bf16_t, OFF_H1); const bf16_t* WDT = WSP(bf16_t, OFF_WIN) + (size_t)6656 * 1024; float* DT = WSP(float, OFF_DT);
    for (int rg = C.bid; rg < MT / 48; rg += C.G) {
        const int R0 = rg * 48;
#pragma unroll 2
        for (int k = 0; k < 6; ++k) { const int lr = 6 * C.wave + k, t = R0 + lr;
            const bool lat = t >= NCTX_TOK; const int mi = mod_idx(t), tt = (t - NCTX_TOK) & 4095;
            const float* xr = lat ? KIN(1) + (size_t)(t - NCTX_TOK) * 1024 : KIN(0) + (size_t)t * 1024;
#pragma unroll
            for (int j = 0; j < 4; ++j) { const int c = 4 * C.lane + 256 * j; f32x4 v = *(const f32x4*)(xr + c);
                if (lat) { const float* pp = c < 512 ? POS + (tt >> 6) * 512 + c : POS + (tt & 63) * 512 + (c - 512); v += *(const f32x4*)pp; }
                const f32x4 sh = *(const LAS f32x4*)(ml + mi * 2048 + c), sc = *(const LAS f32x4*)(ml + mi * 2048 + 1024 + c);
                v = v * (sc + 1.0f) + sh;
                const u32x2 pk = (u32x2){pk_bf16(v[0], v[1]), pk_bf16(v[2], v[3])};
                *(u32x2*)(H1 + (size_t)t * 1024 + c) = pk; *(LAS u32x2*)(HR + lr * HP + c * 2) = pk; } }
        __syncthreads();
        const int rt = C.wave & 1, kq = C.wave >> 1, r = C.lane & 31, hh = C.lane >> 5;
        f32x16 acc = {0};
        { const int ar = (rt * 32 + r) < 48 ? (rt * 32 + r) : 47; const LAS uchar* pa = HR + ar * HP + (kq * 256 + 8 * hh) * 2; const bf16_t* pb = WDT + (size_t)r * 1024 + kq * 256 + 8 * hh;
#pragma unroll
          for (int ks = 0; ks < 16; ++ks) { const bf16x8 av = *(const LAS bf16x8*)(pa + ks * 32); const bf16x8 bv = *(const bf16x8*)(pb + ks * 16); acc = __builtin_amdgcn_mfma_f32_32x32x16_bf16(av, bv, acc, 0, 0, 0); } }
        __syncthreads();
        LAS float* scr = (LAS float*)HR;
#pragma unroll
        for (int e = 0; e < 16; ++e) scr[(C.wave * 16 + e) * 64 + C.lane] = acc[e];
        __syncthreads();
#pragma unroll
        for (int q = 0; q < 3; ++q) { const int idx = C.tid + 512 * q, row = idx >> 5, col = idx & 31, rt2 = row >> 5, rr = row & 31, h2 = (rr >> 2) & 1, e = (rr & 3) + 4 * (rr >> 3), ln = col + 32 * h2; float s = 0.f;
#pragma unroll
            for (int k4 = 0; k4 < 4; ++k4) s += scr[((k4 * 2 + rt2) * 16 + e) * 64 + ln];
            s += col < 16 ? KIN(11)[col] : KIN(12)[col - 16];
            DT[(size_t)(R0 + row) * 32 + col] = softplusf_(s); }
        __syncthreads();
    }
}

constexpr int PITCH = 272;
__device__ __forceinline__ int rowmap(int e, int hh) { return (e & 3) + 8 * (e >> 2) + 4 * hh; }
__device__ __forceinline__ f32x16 mma_k128(const LAS uchar* A, const LAS uchar* B, int lane, f32x16 acc) {
    const int r = lane & 31, hh = lane >> 5; const LAS uchar* pa = A + r * PITCH + hh * 16; const LAS uchar* pb = B + r * PITCH + hh * 16;
#pragma unroll
    for (int ks = 0; ks < 8; ++ks) { const bf16x8 a = *(const LAS bf16x8*)(pa + ks * 32); const bf16x8 b = *(const LAS bf16x8*)(pb + ks * 32); acc = __builtin_amdgcn_mfma_f32_32x32x16_bf16(a, b, acc, 0, 0, 0); }
    return acc;
}
struct CW { f32x4 w0a, w0b, w1a, w1b, w2a, w2b, ba, bb; };
__device__ __forceinline__ CW load_cw(const float* cw, const float* cb, int ch) {
    CW w; w.w0a = *(const f32x4*)(cw + ch); w.w0b = *(const f32x4*)(cw + ch + 4); w.w1a = *(const f32x4*)(cw + 1536 + ch); w.w1b = *(const f32x4*)(cw + 1536 + ch + 4);
    w.w2a = *(const f32x4*)(cw + 3072 + ch); w.w2b = *(const f32x4*)(cw + 3072 + ch + 4); w.ba = *(const f32x4*)(cb + ch); w.bb = *(const f32x4*)(cb + ch + 4); return w;
}
__device__ __forceinline__ u32x4 ld_tok(const bf16_t* XBC, int t, int t0, int t1, int ch) {
    const bool ok = (t >= t0) && (t < t1); const int tc = t < t0 ? t0 : (t >= t1 ? t1 - 1 : t);
    u32x4 v = *(const u32x4*)(XBC + (size_t)tc * 1536 + ch);
    v.x = ok ? v.x : 0u; v.y = ok ? v.y : 0u; v.z = ok ? v.z : 0u; v.w = ok ? v.w : 0u; return v;
}
__device__ __forceinline__ void conv3_silu(const u32x4 vm, const u32x4 v0, const u32x4 vp, const CW& w, float (&o)[8]) {
    float xm[8], x0[8], xp[8]; unpack8(vm, xm); unpack8(v0, x0); unpack8(vp, xp);
#pragma unroll
    for (int e = 0; e < 4; ++e) { o[e] = siluf_(w.w0a[e] * xm[e] + w.w1a[e] * x0[e] + w.w2a[e] * xp[e] + w.ba[e]); o[4 + e] = siluf_(w.w0b[e] * xm[4 + e] + w.w1b[e] * x0[4 + e] + w.w2b[e] * xp[4 + e] + w.bb[e]); }
}
__device__ __forceinline__ u32x4 pack8(const float (&y)[8]) { return (u32x4){pk_bf16(y[0], y[1]), pk_bf16(y[2], y[3]), pk_bf16(y[4], y[5]), pk_bf16(y[6], y[7])}; }
struct CW4 { f32x4 w0, w1, w2, b; };
__device__ __forceinline__ CW4 load_cw4(const float* cw, const float* cb, int ch) { CW4 w; w.w0 = *(const f32x4*)(cw + ch); w.w1 = *(const f32x4*)(cw + 1536 + ch); w.w2 = *(const f32x4*)(cw + 3072 + ch); w.b = *(const f32x4*)(cb + ch); return w; }
__device__ __forceinline__ u32x2 ld_tok4(const bf16_t* XBC, int t, int t0, int t1, int ch) { const bool ok = (t >= t0) && (t < t1); const int tc = t < t0 ? t0 : (t >= t1 ? t1 - 1 : t);
    u32x2 v = *(const u32x2*)(XBC + (size_t)tc * 1536 + ch); v.x = ok ? v.x : 0u; v.y = ok ? v.y : 0u; return v; }
__device__ __forceinline__ u32x2 conv3_silu4(const u32x2 vm, const u32x2 v0, const u32x2 vp, const CW4& w) {
    const float xm[4] = {bf_lo(vm.x), bf_hi(vm.x), bf_lo(vm.y), bf_hi(vm.y)}, x0[4] = {bf_lo(v0.x), bf_hi(v0.x), bf_lo(v0.y), bf_hi(v0.y)}, xp[4] = {bf_lo(vp.x), bf_hi(vp.x), bf_lo(vp.y), bf_hi(vp.y)};
    float o[4];
#pragma unroll
    for (int e = 0; e < 4; ++e) o[e] = siluf_(w.w0[e] * xm[e] + w.w1[e] * x0[e] + w.w2[e] * xp[e] + w.b[e]);
    return (u32x2){pk_bf16(o[0], o[1]), pk_bf16(o[2], o[3])};
}
struct LaneScal { float df0, df1, db0, db1, af0, af1, ab0, ab1, totF, totB; };
__device__ __forceinline__ LaneScal lane_scalars(float df0, float df1, float db0, float db1, float anf, float anb, int lane) {
    LaneScal s; s.df0 = df0; s.df1 = df1; s.db0 = db0; s.db1 = db1;
    const float f0 = df0 * anf, f1 = df1 * anf, b0 = db0 * anb, b1 = db1 * anb;
    float sf = f0 + f1, sb = b0 + b1;
#pragma unroll
    for (int o = 1; o < 64; o <<= 1) { const float tf = __shfl_up(sf, o), tb = __shfl_up(sb, o); if (lane >= o) { sf += tf; sb += tb; } }
    s.totF = __shfl(sf, 63); s.totB = __shfl(sb, 63);
    s.af0 = sf - f1; s.af1 = sf; s.ab0 = s.totB - (sb - b0 - b1); s.ab1 = s.totB - (sb - b1);
    return s;
}

__device__ __forceinline__ void ssd_states_item(Ctx& C, int item) {
    const int chunk = item >> 4, h = item & 15, g = h >> 3, tok0 = chunk * 128; int t0, t1; seq_bounds(chunk, t0, t1);
    LAS uchar* BT = C.lds; LAS uchar* XTF = C.lds + 34816; LAS uchar* XTB = C.lds + 52224;
    const bf16_t* XBC = WSP(bf16_t, OFF_XBC); const float* cw = KIN(9); const float* cb = KIN(10);
    const int pair = C.lane, ta = tok0 + 2 * pair;
    const float* DT = WSP(float, OFF_DT) + (size_t)ta * 32;
    const float df0 = DT[h], df1 = DT[32 + h], db0 = DT[16 + h], db1 = DT[48 + h];
    const float alf = KIN(13)[h], alb = KIN(14)[h];
    const int chx = h * 64 + C.wave * 8, chb0 = 1024 + g * 128 + C.wave * 8, chb1 = chb0 + 64;
    const u32x4 x_m = ld_tok(XBC, ta - 1, t0, t1, chx), x_a = ld_tok(XBC, ta, t0, t1, chx), x_b = ld_tok(XBC, ta + 1, t0, t1, chx), x_p = ld_tok(XBC, ta + 2, t0, t1, chx);
    const u32x4 p_m = ld_tok(XBC, ta - 1, t0, t1, chb0), p_a = ld_tok(XBC, ta, t0, t1, chb0), p_b = ld_tok(XBC, ta + 1, t0, t1, chb0), p_p = ld_tok(XBC, ta + 2, t0, t1, chb0);
    const u32x4 q_m = ld_tok(XBC, ta - 1, t0, t1, chb1), q_a = ld_tok(XBC, ta, t0, t1, chb1), q_b = ld_tok(XBC, ta + 1, t0, t1, chb1), q_p = ld_tok(XBC, ta + 2, t0, t1, chb1);
    const CW wx = load_cw(cw, cb, chx), wb0 = load_cw(cw, cb, chb0), wb1 = load_cw(cw, cb, chb1);
    const LaneScal s = lane_scalars(df0, df1, db0, db1, -__expf(alf), -__expf(alb), C.lane);
    const float wf0 = s.df0 * __expf(s.totF - s.af0), wf1 = s.df1 * __expf(s.totF - s.af1), wbk0 = s.db0 * __expf(s.totB - s.ab0), wbk1 = s.db1 * __expf(s.totB - s.ab1);
    if (C.tid == 0) { float* AL = WSP(float, OFF_AL) + (size_t)(chunk * 16 + h) * 2; AL[0] = s.totF; AL[1] = s.totB; }
    { float y0[8], y1[8]; conv3_silu(p_m, p_a, p_b, wb0, y0); conv3_silu(p_a, p_b, p_p, wb0, y1);
#pragma unroll
      for (int e = 0; e < 8; ++e) *(LAS unsigned*)(BT + (C.wave * 8 + e) * PITCH + pair * 4) = pk_bf16(y0[e], y1[e]);
      conv3_silu(q_m, q_a, q_b, wb1, y0); conv3_silu(q_a, q_b, q_p, wb1, y1);
#pragma unroll
      for (int e = 0; e < 8; ++e) *(LAS unsigned*)(BT + ((C.wave + 8) * 8 + e) * PITCH + pair * 4) = pk_bf16(y0[e], y1[e]);
      conv3_silu(x_m, x_a, x_b, wx, y0); conv3_silu(x_a, x_b, x_p, wx, y1);
#pragma unroll
      for (int e = 0; e < 8; ++e) { *(LAS unsigned*)(XTF + (C.wave * 8 + e) * PITCH + pair * 4) = pk_bf16(y0[e] * wf0, y1[e] * wf1); *(LAS unsigned*)(XTB + (C.wave * 8 + e) * PITCH + pair * 4) = pk_bf16(y0[e] * wbk0, y1[e] * wbk1); } }
    __syncthreads();
    { const int dir = C.wave >> 2, tn = C.wave & 3; const LAS uchar* XT = dir ? XTB : XTF;
        f32x16 a0 = {0}, a1 = {0};
        a0 = mma_k128(XT, BT + tn * 32 * PITCH, C.lane, a0); a1 = mma_k128(XT + 32 * PITCH, BT + tn * 32 * PITCH, C.lane, a1);
        bf16_t* ST = WSP(bf16_t, OFF_ST) + ((size_t)(chunk * 16 + h) * 2 + dir) * 8192; const int n = tn * 32 + (C.lane & 31), hh = C.lane >> 5;
#pragma unroll
        for (int e = 0; e < 16; ++e) { const int p = rowmap(e, hh); ST[p * 128 + n] = to_bf1(a0[e]); ST[(32 + p) * 128 + n] = to_bf1(a1[e]); } }
    __syncthreads();
}

__device__ __forceinline__ void sgu_stats(Ctx& C) {
    f32x2* ST2 = WSP(f32x2, OFF_MODP);
    for (int t = C.bid * NTHREADS + C.tid; t < MT; t += C.G * NTHREADS) { const f32x4* vs = (const f32x4*)(WSP(float, OFF_VSTAT) + (size_t)t * 32); float s = 0.f, ss = 0.f;
#pragma unroll
        for (int k = 0; k < 8; ++k) { const f32x4 v = vs[k]; s += v[0] + v[2]; ss += v[1] + v[3]; }
        const float mu = s * (1.0f / 1024.0f), var = fmaxf(ss * (1.0f / 1024.0f) - mu * mu, 0.f); ST2[t] = (f32x2){mu, rsqrtf(var + EPS)}; }
}

__device__ __forceinline__ void sgu_item(Ctx& C, int item) {
    const int chunk = item >> 3, g = item & 7, tok0 = chunk * 128;
    LAS uchar* WS_ = C.lds; LAS uchar* VT = C.lds + 34816;
    const bf16_t* V = WSP(bf16_t, OFF_V); const f32x2* ST2 = WSP(f32x2, OFF_MODP);
    const int pair = C.lane, ta = tok0 + 2 * pair, d0 = g * 128 + C.wave * 8, d1 = d0 + 64;
    const int ti = C.wave >> 1, td0 = (C.wave & 1) * 2, hh = C.lane >> 5, l31 = C.lane & 31;
    const f32x2 sta = ST2[ta], stb = ST2[ta + 1];
    const u32x4 va0 = *(const u32x4*)(V + (size_t)ta * 1024 + d0), vb0 = *(const u32x4*)(V + (size_t)(ta + 1) * 1024 + d0), va1 = *(const u32x4*)(V + (size_t)ta * 1024 + d1), vb1 = *(const u32x4*)(V + (size_t)(ta + 1) * 1024 + d1);
    const f32x4 g0a = *(const f32x4*)(KIN(17) + d0), g0b = *(const f32x4*)(KIN(17) + d0 + 4), b0a = *(const f32x4*)(KIN(18) + d0), b0b = *(const f32x4*)(KIN(18) + d0 + 4);
    const f32x4 g1a = *(const f32x4*)(KIN(17) + d1), g1b = *(const f32x4*)(KIN(17) + d1 + 4), b1a = *(const f32x4*)(KIN(18) + d1), b1b = *(const f32x4*)(KIN(18) + d1 + 4);
    const u32x4* src = (const u32x4*)(WSP(bf16_t, OFF_WSP) + (size_t)g * 16384);
    u32x4 wv[4];
#pragma unroll
    for (int k = 0; k < 4; ++k) wv[k] = src[C.tid + 512 * k];
    bf16_t* U = (bf16_t*)C.out + 1024;
    bf16_t uv[2][16]; float bs[16];
#pragma unroll
    for (int e = 0; e < 16; ++e) { const int i = ti * 32 + rowmap(e, hh); bs[e] = KIN(20)[g * 128 + i];
#pragma unroll
        for (int q = 0; q < 2; ++q) uv[q][e] = U[(size_t)(tok0 + i) * 2048 + g * 128 + (td0 + q) * 32 + l31]; }
#pragma unroll
    for (int k = 0; k < 4; ++k) { const int v = C.tid + 512 * k, i = v >> 4, c8 = v & 15; *(LAS u32x4*)(WS_ + i * PITCH + c8 * 16) = wv[k]; }
    { float xa[8], xb[8]; unpack8(va0, xa); unpack8(vb0, xb);
#pragma unroll
      for (int e = 0; e < 8; ++e) { const float gg = e < 4 ? g0a[e & 3] : g0b[e & 3], bb = e < 4 ? b0a[e & 3] : b0b[e & 3];
          *(LAS unsigned*)(VT + (C.wave * 8 + e) * PITCH + pair * 4) = pk_bf16((xa[e] - sta[0]) * sta[1] * gg + bb, (xb[e] - stb[0]) * stb[1] * gg + bb); }
      unpack8(va1, xa); unpack8(vb1, xb);
#pragma unroll
      for (int e = 0; e < 8; ++e) { const float gg = e < 4 ? g1a[e & 3] : g1b[e & 3], bb = e < 4 ? b1a[e & 3] : b1b[e & 3];
          *(LAS unsigned*)(VT + ((C.wave + 8) * 8 + e) * PITCH + pair * 4) = pk_bf16((xa[e] - sta[0]) * sta[1] * gg + bb, (xb[e] - stb[0]) * stb[1] * gg + bb); } }
    __syncthreads();
#pragma unroll
    for (int q = 0; q < 2; ++q) { f32x16 acc = {0}; acc = mma_k128(WS_ + ti * 32 * PITCH, VT + (td0 + q) * 32 * PITCH, C.lane, acc);
#pragma unroll
        for (int e = 0; e < 16; ++e) { const int i = ti * 32 + rowmap(e, hh); U[(size_t)(tok0 + i) * 2048 + g * 128 + (td0 + q) * 32 + l31] = to_bf1(bf1(uv[q][e]) * (acc[e] + bs[e])); } }
    __syncthreads();
}

template <int NB> __device__ __forceinline__ void scan_steps(bf16_t* STb, const float* ALb, int c0, int nc, int dir, int k0, float (&hv)[4]) {
    u32x2 sv[NB]; float dec[NB]; u32x2* pp[NB];
#pragma unroll
    for (int k = 0; k < NB; ++k) { const int c = c0 + (dir ? nc - 1 - (k0 + k) : (k0 + k)); pp[k] = (u32x2*)(STb + (size_t)c * 16 * 2 * 8192); sv[k] = *pp[k]; dec[k] = ALb[(size_t)c * 32]; }
#pragma unroll
    for (int k = 0; k < NB; ++k) { const float d = __expf(dec[k]); *pp[k] = (u32x2){pk_bf16(hv[0], hv[1]), pk_bf16(hv[2], hv[3])};
        hv[0] = d * hv[0] + bf_lo(sv[k].x); hv[1] = d * hv[1] + bf_hi(sv[k].x); hv[2] = d * hv[2] + bf_lo(sv[k].y); hv[3] = d * hv[3] + bf_hi(sv[k].y); }
}
__device__ __forceinline__ void scan_item(Ctx& C, int item) {
    int seq, nc, c0; int r = item;
    if (r < 256) { seq = 16 + (r >> 7); r &= 127; nc = 32; c0 = 32 + (seq - 16) * 32; } else { r -= 256; seq = r >> 7; r &= 127; nc = 2; c0 = seq * 2; }
    const int h = r >> 3, dir = (r >> 2) & 1, quarter = r & 3; const int e0 = quarter * 2048 + C.tid * 4;
    float hv[4];
    if (seq >= 16) { const f32x4 v = *(const f32x4*)((dir ? KIN(3) : KIN(2)) + ((size_t)(seq - 16) * 16 + h) * 8192 + e0); hv[0] = v[0]; hv[1] = v[1]; hv[2] = v[2]; hv[3] = v[3]; } else { hv[0] = hv[1] = hv[2] = hv[3] = 0.f; }
    bf16_t* STb = WSP(bf16_t, OFF_ST) + ((size_t)h * 2 + dir) * 8192 + e0; const float* ALb = WSP(float, OFF_AL) + h * 2 + dir;
    if (nc == 32) { for (int k0 = 0; k0 < 32; k0 += 8) scan_steps<8>(STb, ALb, c0, nc, dir, k0, hv); } else scan_steps<2>(STb, ALb, c0, nc, dir, 0, hv);
    if (seq < 16) *(f32x4*)(C.out + 12582912 + (size_t)dir * 2097152 + ((size_t)seq * 16 + h) * 8192 + e0) = (f32x4){hv[0], hv[1], hv[2], hv[3]};
}

__device__ __forceinline__ void ssd_out_item(Ctx& C, int item) {
    const int chunk = item >> 4, h = item & 15, g = h >> 3, tok0 = chunk * 128; int t0, t1; seq_bounds(chunk, t0, t1);
    LAS uchar* CN = C.lds; LAS uchar* BN = C.lds + 34816; LAS uchar* XT = C.lds + 69632; LAS uchar* HF = C.lds + 87040; LAS uchar* HB = C.lds + 104448;
    LAS f32x4* SC = (LAS f32x4*)(C.lds + 121856);
    const bf16_t* XBC = WSP(bf16_t, OFF_XBC); const float* cw = KIN(9); const float* cb = KIN(10);
    const int hh = C.lane >> 5, c = C.lane & 31, ti = C.wave >> 1, tp = C.wave & 1, i = ti * 32 + c;
    const int oc4 = C.tid & 31, jq = C.tid >> 5, tq = tok0 + 8 * jq, chc = 1280 + g * 128 + oc4 * 4, chb = 1024 + g * 128 + oc4 * 4;
    u32x2 rc[10], rb[10];
#pragma unroll
    for (int k = 0; k < 10; ++k) { rc[k] = ld_tok4(XBC, tq - 1 + k, t0, t1, chc); rb[k] = ld_tok4(XBC, tq - 1 + k, t0, t1, chb); }
    const int pair = C.lane, ta = tok0 + 2 * pair, chx = h * 64 + C.wave * 8;
    const u32x4 x_m = ld_tok(XBC, ta - 1, t0, t1, chx), x_a = ld_tok(XBC, ta, t0, t1, chx), x_b = ld_tok(XBC, ta + 1, t0, t1, chx), x_p = ld_tok(XBC, ta + 2, t0, t1, chx);
    const u32x4* hs = (const u32x4*)(WSP(bf16_t, OFF_ST) + (size_t)(chunk * 16 + h) * 2 * 8192);
    const u32x4 hf0 = hs[C.tid], hf1 = hs[C.tid + 512], hb0 = hs[1024 + C.tid], hb1 = hs[1536 + C.tid];
    const float* DT = WSP(float, OFF_DT) + (size_t)ta * 32;
    const float df0 = DT[h], df1 = DT[32 + h], db0 = DT[16 + h], db1 = DT[48 + h];
    const float alf = KIN(13)[h], alb = KIN(14)[h];
    const CW4 wc = load_cw4(cw, cb, chc), wb = load_cw4(cw, cb, chb);
    bf16_t* zrow = (bf16_t*)C.out + (size_t)(tok0 + i) * 2048 + h * 64 + tp * 32 + 4 * hh;
    u32x2 zq[4];
#pragma unroll
    for (int q = 0; q < 4; ++q) zq[q] = *(const u32x2*)(zrow + 8 * q);
    const float dsk = KIN(15)[h];
    if (C.wave == 0) { const LaneScal s = lane_scalars(df0, df1, db0, db1, -__expf(alf), -__expf(alb), C.lane); const int j0 = 2 * C.lane;
        SC[j0] = (f32x4){s.af0, s.ab0, df0, db0}; SC[j0 + 1] = (f32x4){s.af1, s.ab1, df1, db1}; }
    {
#pragma unroll
      for (int k = 0; k < 8; ++k) { *(LAS u32x2*)(CN + (8 * jq + k) * PITCH + oc4 * 8) = conv3_silu4(rc[k], rc[k + 1], rc[k + 2], wc);
                                    *(LAS u32x2*)(BN + (8 * jq + k) * PITCH + oc4 * 8) = conv3_silu4(rb[k], rb[k + 1], rb[k + 2], wb); }
      asm volatile("" ::: "memory");
      const CW wx = load_cw(cw, cb, chx);
      float y0[8], y1[8]; conv3_silu(x_m, x_a, x_b, wx, y0); conv3_silu(x_a, x_b, x_p, wx, y1);
#pragma unroll
      for (int e = 0; e < 8; ++e) *(LAS unsigned*)(XT + (C.wave * 8 + e) * PITCH + pair * 4) = pk_bf16(y0[e], y1[e]); }
    { const int p0 = C.tid >> 4, c8 = C.tid & 15; *(LAS u32x4*)(HF + p0 * PITCH + c8 * 16) = hf0; *(LAS u32x4*)(HF + (p0 + 32) * PITCH + c8 * 16) = hf1; *(LAS u32x4*)(HB + p0 * PITCH + c8 * 16) = hb0; *(LAS u32x4*)(HB + (p0 + 32) * PITCH + c8 * 16) = hb1; }
    __syncthreads();
    const f32x4 sci = SC[i]; const float AFi = sci[0], ABi = sci[1];
    f32x16 ad = {0}, af = {0}, ab = {0};
    af = mma_k128(HF + tp * 32 * PITCH, CN + ti * 32 * PITCH, C.lane, af);
    ab = mma_k128(HB + tp * 32 * PITCH, CN + ti * 32 * PITCH, C.lane, ab);
    const LAS uchar* xrow = XT + (tp * 32 + c) * PITCH + 8 * hh;
#pragma unroll
    for (int tj = 0; tj < 4; ++tj) {
        f32x16 X = {0}; X = mma_k128(BN + tj * 32 * PITCH, CN + ti * 32 * PITCH, C.lane, X);
#pragma unroll
        for (int e = 0; e < 16; ++e) { const int j = tj * 32 + rowmap(e, hh); const f32x4 scj = SC[j]; float w = 0.f;
            if (j <= i) w += __expf(AFi - scj[0]) * scj[2];
            if (j >= i) w += __expf(ABi - scj[1]) * scj[3];
            X[e] = X[e] * w + (i == j ? dsk : 0.f); }
#pragma unroll
        for (int s = 0; s < 2; ++s) {
            const u32x4 bw = (u32x4){pk_bf16(X[8 * s], X[8 * s + 1]), pk_bf16(X[8 * s + 2], X[8 * s + 3]), pk_bf16(X[8 * s + 4], X[8 * s + 5]), pk_bf16(X[8 * s + 6], X[8 * s + 7])};
            const u32x2 a_lo = *(const LAS u32x2*)(xrow + (tj * 32 + 16 * s) * 2), a_hi = *(const LAS u32x2*)(xrow + (tj * 32 + 16 * s) * 2 + 16);
            const u32x4 aw = (u32x4){a_lo.x, a_lo.y, a_hi.x, a_hi.y};
            ad = __builtin_amdgcn_mfma_f32_32x32x16_bf16(__builtin_bit_cast(bf16x8, aw), __builtin_bit_cast(bf16x8, bw), ad, 0, 0, 0);
        }
    }
    {
        const float ef = __expf(AFi), eb = __expf(ABi); float ss = 0.f;
#pragma unroll
        for (int q = 0; q < 4; ++q) { const f32x4 nw = *(const f32x4*)(KIN(16) + h * 64 + tp * 32 + 8 * q + 4 * hh);
            const float z[4] = {bf_lo(zq[q].x), bf_hi(zq[q].x), bf_lo(zq[q].y), bf_hi(zq[q].y)}; float o[4];
#pragma unroll
            for (int k = 0; k < 4; ++k) { const int e = 4 * q + k; const float y = ad[e] + ef * af[e] + eb * ab[e]; const float gz = y * z[k]; ss += gz * gz; o[k] = gz * nw[k]; }
            *(u32x2*)(zrow + 8 * q) = (u32x2){pk_bf16(o[0], o[1]), pk_bf16(o[2], o[3])}; }
        ss += __shfl_xor(ss, 32);
        if (hh == 0) WSP(float, OFF_SSQ)[(size_t)(tok0 + i) * 32 + h * 2 + tp] = ss;
    }
    __syncthreads();
}

__device__ __forceinline__ void ln1_pass(Ctx& C) {
    float* R1 = WSP(float, OFF_XBC); bf16_t* H2 = WSP(bf16_t, OFF_ZS); const float* MOD = WSP(float, OFF_MOD);
    const int gw = C.bid * 8 + C.wave, NGW = C.G * 8;
    for (int t = gw; t < MT; t += NGW) { const int mi = mod_idx(t); float* rp = R1 + (size_t)t * 1024; f32x4 v[4]; float s = 0.f;
#pragma unroll
        for (int j = 0; j < 4; ++j) { v[j] = *(const f32x4*)(rp + 4 * C.lane + 256 * j); s += (v[j][0] + v[j][1]) + (v[j][2] + v[j][3]); }
        const float mean = wave_sum(s) * (1.0f / 1024.0f); float q = 0.f;
#pragma unroll
        for (int j = 0; j < 4; ++j) { v[j] = v[j] - mean; q += (v[j][0] * v[j][0] + v[j][1] * v[j][1]) + (v[j][2] * v[j][2] + v[j][3] * v[j][3]); }
        const float rstd = rsqrtf(wave_sum(q) * (1.0f / 1024.0f) + EPS);
#pragma unroll
        for (int j = 0; j < 4; ++j) { const int c = 4 * C.lane + 256 * j; const f32x4 x1 = v[j] * rstd * *(const f32x4*)(KIN(24) + c) + *(const f32x4*)(KIN(25) + c);
            *(f32x4*)(rp + c) = x1;
            const f32x4 hv = x1 * (*(const f32x4*)(MOD + mi * 6144 + 4096 + c) + 1.0f) + *(const f32x4*)(MOD + mi * 6144 + 3072 + c);
            *(u32x2*)(H2 + (size_t)t * 1024 + c) = (u32x2){pk_bf16(hv[0], hv[1]), pk_bf16(hv[2], hv[3])}; }
    }
}
__device__ __forceinline__ void ln2_pass(Ctx& C) {
    const int gw = C.bid * 8 + C.wave, NGW = C.G * 8;
    for (int t = gw; t < MT; t += NGW) { float* rp = C.out + (size_t)t * 1024; f32x4 v[4]; float s = 0.f;
#pragma unroll
        for (int j = 0; j < 4; ++j) { v[j] = *(const f32x4*)(rp + 4 * C.lane + 256 * j); s += (v[j][0] + v[j][1]) + (v[j][2] + v[j][3]); }
        const float mean = wave_sum(s) * (1.0f / 1024.0f); float q = 0.f;
#pragma unroll
        for (int j = 0; j < 4; ++j) { v[j] = v[j] - mean; q += (v[j][0] * v[j][0] + v[j][1] * v[j][1]) + (v[j][2] * v[j][2] + v[j][3] * v[j][3]); }
        const float rstd = rsqrtf(wave_sum(q) * (1.0f / 1024.0f) + EPS);
#pragma unroll
        for (int j = 0; j < 4; ++j) { const int c = 4 * C.lane + 256 * j; *(f32x4*)(rp + c) = v[j] * rstd * *(const f32x4*)(KIN(28) + c) + *(const f32x4*)(KIN(29) + c); }
    }
}

#define XB_TMO      128
#define XB_XCNT(j)  (256  + 64 * (j))
#define XB_XSUB(j)  (1280 + 64 * (j))
#define XB_XGEN(j)  (2304 + 64 * (j))
#define XB_TOP      3328
#define XB_TOPGEN   3392
#define XCD_BAR_WORDS 3456
#define XB_SPIN_CAP (1u << 18)

__device__ __forceinline__ unsigned xb_ld(unsigned* p)              { return __hip_atomic_load(p, __ATOMIC_RELAXED, __HIP_MEMORY_SCOPE_AGENT); }
__device__ __forceinline__ unsigned xb_add(unsigned* p, unsigned v) { return __hip_atomic_fetch_add(p, v, __ATOMIC_RELAXED, __HIP_MEMORY_SCOPE_AGENT); }
__device__ __forceinline__ unsigned xb_xcc_id() { return (unsigned)__builtin_amdgcn_s_getreg((3 << 11) | 20) & 0xFu; }
#define XB_SPIN(cond, bar) do { unsigned _sp = 0; while (cond) { __builtin_amdgcn_s_sleep(1); \
    if ((++_sp & 255u) == 0u) { if (xb_ld(&(bar)[XB_TMO])) break; if (_sp > XB_SPIN_CAP) { atomicAdd(&(bar)[XB_TMO], 1u); break; } } } } while (0)

struct XcdBarrier {
    unsigned* bar; unsigned x;
    volatile LAS unsigned* st;
};

__device__ __forceinline__ XcdBarrier xcd_barrier_post(unsigned* bar, volatile LAS unsigned* st) {
    XcdBarrier b; b.bar = bar; b.x = xb_xcc_id(); b.st = st;
    if (threadIdx.x == 0) (void)xb_add(&bar[XB_XCNT(b.x)], 1u);
    return b;
}
__device__ __forceinline__ void xcd_barrier_complete(unsigned* bar, unsigned x, unsigned& nloc, unsigned& nx) {
    const unsigned G = gridDim.x * gridDim.y * gridDim.z;
    unsigned sum, cnt, mine, sp = 0u;
    for (;;) {
        sum = 0u; cnt = 0u; mine = 0u;
#pragma unroll
        for (unsigned j = 0; j < 16; ++j) { const unsigned c = xb_ld(&bar[XB_XCNT(j)]); sum += c; cnt += (c > 0u) ? 1u : 0u; mine = (j == x) ? c : mine; }
        if (sum == G) break;
        __builtin_amdgcn_s_sleep(1);
        if ((++sp & 255u) == 0u) { if (xb_ld(&bar[XB_TMO])) break; if (sp > XB_SPIN_CAP) { atomicAdd(&bar[XB_TMO], 1u); break; } }
    }
    nloc = mine > 0u ? mine : 1u; nx = cnt > 0u ? cnt : 1u;
}

__device__ __forceinline__ void xcd_barrier(const XcdBarrier& b) {
    asm volatile("s_waitcnt vmcnt(0)" ::: "memory");
    __syncthreads();
    if (threadIdx.x == 0) {
        unsigned* bar = b.bar;
        __builtin_amdgcn_s_waitcnt(0);
        unsigned nloc = b.st[0], nx = b.st[1];
        if (nloc == 0u) { xcd_barrier_complete(bar, b.x, nloc, nx); b.st[0] = nloc; b.st[1] = nx; }
        const unsigned old = xb_add(&bar[XB_XSUB(b.x)], 1u);
        const unsigned gen = old / nloc;
        if (old + 1u == (gen + 1u) * nloc) {
            __builtin_amdgcn_fence(__ATOMIC_RELEASE, "agent");
            asm volatile("s_waitcnt vmcnt(0)" ::: "memory");
            const unsigned og = xb_add(&bar[XB_TOP], 1u);
            const unsigned tg = og / nx;
            if (og + 1u == (tg + 1u) * nx) xb_add(&bar[XB_TOPGEN], 1u);
            else XB_SPIN(xb_ld(&bar[XB_TOPGEN]) == tg, bar);
            __builtin_amdgcn_fence(__ATOMIC_ACQUIRE, "agent");
            xb_add(&bar[XB_XGEN(b.x)], 1u);
            asm volatile("s_waitcnt vmcnt(0)" ::: "memory");
        } else {
            XB_SPIN(xb_ld(&bar[XB_XGEN(b.x)]) == gen, bar);
            __builtin_amdgcn_fence(__ATOMIC_ACQUIRE, "agent");
            asm volatile("s_waitcnt vmcnt(0)" ::: "memory");
        }
    }
    __syncthreads();
}

constexpr int NPHASE = 12;
__global__ void __launch_bounds__(NTHREADS, 2) fwd_kernel(Args a) {
    extern __shared__ __attribute__((aligned(16))) unsigned char smem[];
    cg::grid_group grid = cg::this_grid();
    Ctx C;
    C.out = a.out; C.ws = a.ws; C.lds = (LAS uchar*)smem; C.tid = threadIdx.x; C.lane = C.tid & 63; C.wave = __builtin_amdgcn_readfirstlane(C.tid >> 6); C.G = gridDim.x; C.bid = blockIdx.x;
    const int lo = a.ph_lo, hi = a.ph_hi;
    volatile LAS unsigned* bst = (volatile LAS unsigned*)(C.lds + 131072);
    if (C.tid < 16) bst[C.tid] = 0u;
    __syncthreads();
    XcdBarrier bar; bar.bar = (unsigned*)(C.ws + OFF_CTL); bar.x = 0; bar.st = bst;
    if (hi - lo > 1) bar = xcd_barrier_post((unsigned*)(C.ws + OFF_CTL), bst);
    if (hi > NPHASE) grid.sync();
#define IN(k) (lo <= (k) && (k) < hi)
#define SEAM(k) do { if (IN(k) && IN((k) + 1)) xcd_barrier(bar); } while (0)
    if (IN(0)) { phase0(C); if (DUP == 1) { __syncthreads(); phase0(C); } }
    if (DUP == 100) { for (int q_ = 0; q_ < 10; ++q_) xcd_barrier(bar); }
    SEAM(0);
    if (IN(1)) { phase1(C); if (DUP == 2) { __syncthreads(); phase1(C); } }
    SEAM(1);
    if (IN(2)) {
        pg8::Gemm g{WSP(bf16_t, OFF_H1), WSP(bf16_t, OFF_WIN), MT, NIN, 1024, 1024}; pg8::StaticOrder S; S.init(MT, NIN, C.G, C.bid);
        EpiIn E{(bf16_t*)C.out, WSP(bf16_t, OFF_XBC), (bf16_t*)C.out + 1024, WSP(bf16_t, OFF_V), WSP(bf16_t, OFF_G), WSP(float, OFF_DT), WSP(float, OFF_VSTAT), KIN(11), KIN(12)};
        pg8::gemm_phase<EpiIn, pg8::StaticOrder, false>(C.lds, g, S, E, nullptr);
        if (DUP == 3) { __syncthreads(); pg8::gemm_phase<EpiIn, pg8::StaticOrder, false>(C.lds, g, S, E, nullptr); }
    }
    SEAM(2);
    const int vcu = (C.G % 8 == 0) ? (C.bid % 8) * (C.G / 8) + C.bid / 8 : C.bid;
    if (IN(3)) { for (int it = vcu; it < 1536; it += C.G) ssd_states_item(C, it); sgu_stats(C); }
    if (DUP == 4 && IN(3)) { for (int it = C.bid; it < 1536; it += C.G) ssd_states_item(C, it); }
    SEAM(3);
    if (IN(4)) { for (int it = C.bid; it < 2304; it += C.G) scan_item(C, it); if (C.G % 8 == 0) { for (int ck = C.bid / 8; ck < NCHUNK; ck += C.G / 8) sgu_item(C, ck * 8 + (C.bid % 8)); } else { for (int it = C.bid; it < 768; it += C.G) sgu_item(C, it); } }
    SEAM(4);
    if (IN(5)) { for (int it = vcu; it < 1536; it += C.G) ssd_out_item(C, it); }
    SEAM(5);
    if (IN(6)) {
        pg8::Gemm g{(const bf16_t*)C.out, WSP(bf16_t, OFF_WPA), MT, 1024, 1024, 2048}; pg8::ChainOrder S; S.init(MT, 1024, C.G, C.bid);
        LAS float* RS = (LAS float*)(C.lds + 131072 + 64);
        for (int ui = 0; ui < 4; ++ui) { pg8::Unit u; if (!S.next(2 * ui, u)) break;
            if (C.tid < 256) { const f32x4* sq = (const f32x4*)(WSP(float, OFF_SSQ) + (size_t)(u.pm * 256 + C.tid) * 32); float tot = 0.f;
#pragma unroll
                for (int k = 0; k < 8; ++k) { const f32x4 q = sq[k]; tot += (q[0] + q[1]) + (q[2] + q[3]); }
                RS[ui * 256 + C.tid] = rsqrtf(tot * (1.0f / 1024.0f) + EPS); } }
        __syncthreads();
        EpiPAB E{WSP(bf16_t, OFF_G), RS, WSP(bf16_t, OFF_H1)};
        pg8::gemm_phase<EpiPAB, pg8::ChainOrder, false>(C.lds, g, S, E, nullptr);
    }
    SEAM(6);
    if (IN(7)) {
        pg8::Gemm g{WSP(bf16_t, OFF_H1), WSP(bf16_t, OFF_WOUT), MT, 1024, 1024, 1024}; pg8::StaticOrder S; S.init(MT, 1024, C.G, C.bid);
        EpiRes E{WSP(float, OFF_XBC), KIN(0), KIN(1), WSP(float, OFF_POS), WSP(float, OFF_MOD) + 2048, 1};
        pg8::gemm_phase<EpiRes, pg8::StaticOrder, false>(C.lds, g, S, E, nullptr);
    }
    SEAM(7);
    if (IN(8)) ln1_pass(C);
    SEAM(8);
    if (IN(9)) {
        pg8::Gemm g{WSP(bf16_t, OFF_ZS), WSP(bf16_t, OFF_WFF1), MT, DFF, 1024, 1024}; pg8::StaticOrder S; S.init(MT, DFF, C.G, C.bid);
        EpiFF1 E{WSP(bf16_t, OFF_G)};
        pg8::gemm_phase<EpiFF1, pg8::StaticOrder, false>(C.lds, g, S, E, nullptr);
        if (DUP == 10) { __syncthreads(); pg8::gemm_phase<EpiFF1, pg8::StaticOrder, false>(C.lds, g, S, E, nullptr); }
    }
    SEAM(9);
    if (IN(10)) {
        pg8::Gemm g{WSP(bf16_t, OFF_G), WSP(bf16_t, OFF_WFF2), MT, 1024, DFF, DFF}; pg8::StaticOrder S; S.init(MT, 1024, C.G, C.bid);
        EpiRes E{C.out, WSP(float, OFF_XBC), nullptr, nullptr, WSP(float, OFF_MOD) + 5120, 0};
        pg8::gemm_phase<EpiRes, pg8::StaticOrder, false>(C.lds, g, S, E, nullptr);
        if (DUP == 11) { __syncthreads(); pg8::gemm_phase<EpiRes, pg8::StaticOrder, false>(C.lds, g, S, E, nullptr); }
    }
    SEAM(10);
    if (IN(11)) ln2_pass(C);
#undef IN
#undef SEAM
}

extern "C" void kernel_launch(void* const* d_in, const int* in_sizes, int n_in, void* d_out, int out_size, void* d_ws, size_t ws_size, hipStream_t stream) {
    static int grid = 0;
    if (grid == 0) {
        if (n_in != 30 || out_size != 16777216 || ws_size < WS_END) { fprintf(stderr, "kernel_launch: unexpected shapes (n_in %d out %d ws %zu)\n", n_in, out_size, ws_size); grid = -1; return; }
        int dev = 0, cus = 0, per_cu = 0;
        (void)hipGetDevice(&dev); (void)hipDeviceGetAttribute(&cus, hipDeviceAttributeMultiprocessorCount, dev);
        if (hipFuncSetAttribute((const void*)fwd_kernel, hipFuncAttributeMaxDynamicSharedMemorySize, LDS_BYTES) != hipSuccess) { fprintf(stderr, "hipFuncSetAttribute failed\n"); grid = -1; return; }
        if (hipOccupancyMaxActiveBlocksPerMultiprocessor(&per_cu, (const void*)fwd_kernel, NTHREADS, LDS_BYTES) != hipSuccess || per_cu < 1) per_cu = 1;
        (void)hipGetLastError();
        grid = cus > 0 ? cus : 256;
    }
    if (grid < 0) return;
    Args a{};
    for (int i = 0; i < 30; ++i) a.in[i] = (const float*)d_in[i];
    a.out = (float*)d_out; a.ws = (unsigned char*)d_ws;
    if (hipMemsetAsync((char*)d_ws + OFF_CTL, 0, 16384, stream) != hipSuccess) { fprintf(stderr, "memset failed\n"); return; }
#if MULTI_LAUNCH
    for (int ph = 0; ph < NPHASE; ++ph) { a.ph_lo = ph; a.ph_hi = ph + 1; hipLaunchKernelGGL(fwd_kernel, dim3(grid), dim3(NTHREADS), LDS_BYTES, stream, a); }
#else
    a.ph_lo = 0; a.ph_hi = NPHASE;
    void* args[] = {&a};
    hipError_t e = hipLaunchCooperativeKernel((const void*)fwd_kernel, dim3(grid), dim3(NTHREADS), args, LDS_BYTES, stream);
    if (e != hipSuccess) fprintf(stderr, "cooperative launch failed: %s (grid %d)\n", hipGetErrorString(e), grid);
#endif
}
```
